# Optimizing an MI355X kernel written in HIP

```python
import jax, jax.numpy as jnp
from jax import lax
import numpy as np

D_MODEL = 1024
BATCH = 2
SEQ = 8192
DEPTH = 1
DEC_BATCH = 2
DEC_SEQ = 16384
PAST_LEN = 128

HEAD_DIM = 64
DILATED_PAIRS = ((128, 1), (512, 4), (2048, 16))
A_HEADS_PER_GROUP = 4
A_GROUPS = len(DILATED_PAIRS)
A_HEADS = A_HEADS_PER_GROUP * A_GROUPS
A_OUT = A_HEADS_PER_GROUP * HEAD_DIM
B_HEADS = 8
A_WIDTH = A_HEADS * HEAD_DIM
B_WIDTH = B_HEADS * HEAD_DIM
GATE_WIDTH = 2 * D_MODEL
IN_WIDTH = 3 * A_WIDTH + 3 * B_WIDTH + GATE_WIDTH
GRID_W = 64
NA_ROWS = 8
NA_COLS = 16
ROPE_THETA = 500000.0
ROT_DIM = HEAD_DIM // 4
D_FF = 2816
RMS_EPS = 1e-6
NEG = -1e30

kernel_name = "hybrid_dilated_neighbourhood_encoder"


def rms_norm(x, g):
    xf = x.astype(jnp.float32)
    y = xf * lax.rsqrt(jnp.mean(xf * xf, axis=-1, keepdims=True) + RMS_EPS)
    return (y * g.astype(jnp.float32)).astype(x.dtype)


def swiglu(h, w_gate, w_up, w_down):
    return (jax.nn.silu(h @ w_gate) * (h @ w_up)) @ w_down


def partial_rotary(x):
    S = x.shape[1]
    half = ROT_DIM // 2
    inv_freq = ROPE_THETA ** (-jnp.arange(0, ROT_DIM, 2, dtype=jnp.float32) / ROT_DIM)
    ang = jnp.arange(S, dtype=jnp.float32)[:, None] * inv_freq[None, :]
    cos = jnp.cos(ang)[None, :, None, :]
    sin = jnp.sin(ang)[None, :, None, :]
    xr = x[..., :ROT_DIM].astype(jnp.float32)
    x1, x2 = xr[..., :half], xr[..., half:]
    rot = jnp.concatenate([x1 * cos - x2 * sin, x2 * cos + x1 * sin], axis=-1).astype(x.dtype)
    return jnp.concatenate([rot, x[..., ROT_DIM:]], axis=-1)


def dilated_window_group(q, k, v, window, dilation):
    B, S, H, E = q.shape
    R = window // (2 * dilation)
    L = S // dilation
    nb = -(-L // R)
    Lp = nb * R

    def to_sub(x):
        return x.reshape(B, L, dilation, H, E).transpose(0, 2, 1, 3, 4)

    qb = jnp.pad(to_sub(q), ((0, 0), (0, 0), (0, Lp - L), (0, 0), (0, 0)))
    qb = qb.reshape(B, dilation, nb, R, H, E)

    def windows(x):
        xp = jnp.pad(to_sub(x), ((0, 0), (0, 0), (R, Lp - L + R), (0, 0), (0, 0)))
        xb = xp.reshape(B, dilation, nb + 2, R, H, E)
        return jnp.concatenate([xb[:, :, :-2], xb[:, :, 1:-1], xb[:, :, 2:]], axis=3)

    kw = windows(k)
    vw = windows(v)
    s = jnp.einsum('bdnqhe,bdnkhe->bdnhqk', qb, kw).astype(jnp.float32) * (E ** -0.5)
    qpos = (jnp.arange(nb) * R)[:, None] + jnp.arange(R)[None, :]
    kpos = (jnp.arange(nb) * R - R)[:, None] + jnp.arange(3 * R)[None, :]
    valid = (jnp.abs(kpos[:, None, :] - qpos[:, :, None]) <= R) \
        & (kpos >= 0)[:, None, :] & (kpos < L)[:, None, :]
    s = jnp.where(valid[None, None, :, None], s, NEG)
    lse = jax.nn.logsumexp(s, axis=-1)
    p = jnp.exp(s - lse[..., None])
    o = jnp.einsum('bdnhqk,bdnkhe->bdnqhe', p.astype(v.dtype), vw)
    o = o.reshape(B, dilation, Lp, H, E)[:, :, :L]
    o = o.transpose(0, 2, 1, 3, 4).reshape(B, S, H, E)
    lse = lse.transpose(0, 1, 2, 4, 3).reshape(B, dilation, Lp, H)[:, :, :L]
    lse = lse.transpose(0, 2, 1, 3).reshape(B, S, H)
    return o, lse


def neighbourhood_attention(q, k, v, rpb):
    B, S, H, E = q.shape
    rows = S // GRID_W
    kh = min(NA_ROWS, rows)
    qg = q.reshape(B, rows, GRID_W, H, E)
    kg = k.reshape(B, rows, GRID_W, H, E)
    vg = v.reshape(B, rows, GRID_W, H, E)
    ri = jnp.arange(rows)
    rs = jnp.clip(ri - kh // 2, 0, rows - kh)
    row_idx = rs[:, None] + jnp.arange(kh)[None, :]
    k_rows = kg[:, row_idx]
    v_rows = vg[:, row_idx]
    cj = jnp.arange(GRID_W)
    cs = jnp.clip(cj - NA_COLS // 2, 0, GRID_W - NA_COLS)
    col_valid = (cj[None, :] >= cs[:, None]) & (cj[None, :] < cs[:, None] + NA_COLS)
    dr_idx = row_idx - ri[:, None] + (NA_ROWS - 1)
    dc_idx = jnp.clip(cj[None, :] - cj[:, None] + (NA_COLS - 1), 0, 2 * NA_COLS - 2)
    bias = rpb[:, dr_idx[:, None, :, None], dc_idx[None, :, None, :]]
    bias = bias.transpose(1, 0, 2, 3, 4).astype(jnp.float32)
    s = jnp.einsum('brqhe,brakhe->brhqak', qg, k_rows).astype(jnp.float32) * (E ** -0.5)
    s = jnp.where(col_valid[:, None, :], s + bias[None], NEG)
    p = jax.nn.softmax(s.reshape(B, rows, H, GRID_W, kh * GRID_W), axis=-1)
    p = p.reshape(B, rows, H, GRID_W, kh, GRID_W).astype(v.dtype)
    o = jnp.einsum('brhqak,brakhe->brqhe', p, v_rows)
    return o.reshape(B, S, H, E)


def token_mixer(h, w_in, b_gate, rpb, w_branch_a, w_branch_b, w_out):
    B, S, _ = h.shape
    proj = h @ w_in
    o0 = 0
    qa = proj[..., o0:o0 + A_WIDTH].reshape(B, S, A_HEADS, HEAD_DIM); o0 += A_WIDTH
    ka = proj[..., o0:o0 + A_WIDTH].reshape(B, S, A_HEADS, HEAD_DIM); o0 += A_WIDTH
    va = proj[..., o0:o0 + A_WIDTH].reshape(B, S, A_HEADS, HEAD_DIM); o0 += A_WIDTH
    qb = proj[..., o0:o0 + B_WIDTH].reshape(B, S, B_HEADS, HEAD_DIM); o0 += B_WIDTH
    kb = proj[..., o0:o0 + B_WIDTH].reshape(B, S, B_HEADS, HEAD_DIM); o0 += B_WIDTH
    vb = proj[..., o0:o0 + B_WIDTH].reshape(B, S, B_HEADS, HEAD_DIM); o0 += B_WIDTH
    g = proj[..., o0:o0 + GATE_WIDTH] + b_gate

    qa = partial_rotary(qa)
    ka = partial_rotary(ka)
    outs, lses = [], []
    for gi, (window, dilation) in enumerate(DILATED_PAIRS):
        sl = slice(gi * A_HEADS_PER_GROUP, (gi + 1) * A_HEADS_PER_GROUP)
        o, lse = dilated_window_group(qa[:, :, sl], ka[:, :, sl], va[:, :, sl], window, dilation)
        outs.append(o)
        lses.append(lse)
    alpha = jax.nn.softmax(jnp.stack(lses, axis=0), axis=0)
    oa = jnp.sum(alpha[..., None] * jnp.stack(outs, axis=0).astype(jnp.float32), axis=0)
    ya = oa.astype(h.dtype).reshape(B, S, A_OUT) @ w_branch_a

    ob = neighbourhood_attention(qb, kb, vb, rpb)
    yb = ob.reshape(B, S, B_WIDTH) @ w_branch_b

    gates = jax.nn.sigmoid(g.astype(jnp.float32)).astype(h.dtype)
    ga, gb = gates[..., :D_MODEL], gates[..., D_MODEL:]
    return (ga * ya + gb * yb) @ w_out


def encoder_stack(x, ffn1_pre_g, ffn1_post_g, ffn1_w_gate, ffn1_w_up, ffn1_w_down,
                  mix_pre_g, mix_post_g, w_in, b_gate, rpb, w_branch_a, w_branch_b, w_out,
                  ffn2_pre_g, ffn2_post_g, ffn2_w_gate, ffn2_w_up, ffn2_w_down):
    for l in range(DEPTH):
        h = rms_norm(x, ffn1_pre_g[l])
        x = x + 0.5 * rms_norm(swiglu(h, ffn1_w_gate[l], ffn1_w_up[l], ffn1_w_down[l]), ffn1_post_g[l])
        h = rms_norm(x, mix_pre_g[l])
        m = token_mixer(h, w_in[l], b_gate[l], rpb[l], w_branch_a[l], w_branch_b[l], w_out[l])
        x = x + rms_norm(m, mix_post_g[l])
        h = rms_norm(x, ffn2_pre_g[l])
        x = x + 0.5 * rms_norm(swiglu(h, ffn2_w_gate[l], ffn2_w_up[l], ffn2_w_down[l]), ffn2_post_g[l])
    return x


def setup_inputs(seed: int = 0) -> dict:
    key = jax.random.key(seed)
    ks = jax.random.split(key, 20)
    f32 = jnp.float32

    def nrm(k, shape, scale):
        return jax.random.normal(k, shape, f32) * scale

    def gain(k):
        return 1.0 + 0.1 * jax.random.normal(k, (DEPTH, D_MODEL), f32)

    return {
        "x_prompt": jax.random.normal(ks[0], (BATCH, SEQ, D_MODEL), f32),
        "x_sample": jax.random.normal(ks[1], (DEC_BATCH, DEC_SEQ, D_MODEL), f32),
        "ffn1_pre_g": gain(ks[2]),
        "ffn1_post_g": gain(ks[3]),
        "ffn1_w_gate": nrm(ks[4], (DEPTH, D_MODEL, D_FF), D_MODEL ** -0.5),
        "ffn1_w_up": nrm(ks[5], (DEPTH, D_MODEL, D_FF), D_MODEL ** -0.5),
        "ffn1_w_down": nrm(ks[6], (DEPTH, D_FF, D_MODEL), D_FF ** -0.5),
        "mix_pre_g": gain(ks[7]),
        "mix_post_g": gain(ks[8]),
        "w_in": nrm(ks[9], (DEPTH, D_MODEL, IN_WIDTH), D_MODEL ** -0.5),
        "b_gate": nrm(ks[10], (DEPTH, GATE_WIDTH), 0.1),
        "rpb": nrm(ks[11], (DEPTH, B_HEADS, 2 * NA_ROWS - 1, 2 * NA_COLS - 1), 0.5),
        "w_branch_a": nrm(ks[12], (DEPTH, A_OUT, D_MODEL), A_OUT ** -0.5),
        "w_branch_b": nrm(ks[13], (DEPTH, B_WIDTH, D_MODEL), B_WIDTH ** -0.5),
        "w_out": nrm(ks[14], (DEPTH, D_MODEL, D_MODEL), D_MODEL ** -0.5),
        "ffn2_pre_g": gain(ks[15]),
        "ffn2_post_g": gain(ks[16]),
        "ffn2_w_gate": nrm(ks[17], (DEPTH, D_MODEL, D_FF), D_MODEL ** -0.5),
        "ffn2_w_up": nrm(ks[18], (DEPTH, D_MODEL, D_FF), D_MODEL ** -0.5),
        "ffn2_w_down": nrm(ks[19], (DEPTH, D_FF, D_MODEL), D_FF ** -0.5),
    }


def reference(x_prompt, x_sample, ffn1_pre_g, ffn1_post_g, ffn1_w_gate, ffn1_w_up, ffn1_w_down,
              mix_pre_g, mix_post_g, w_in, b_gate, rpb, w_branch_a, w_branch_b, w_out,
              ffn2_pre_g, ffn2_post_g, ffn2_w_gate, ffn2_w_up, ffn2_w_down):
    y_prompt = encoder_stack(x_prompt, ffn1_pre_g, ffn1_post_g, ffn1_w_gate, ffn1_w_up, ffn1_w_down,
                             mix_pre_g, mix_post_g, w_in, b_gate, rpb, w_branch_a, w_branch_b, w_out,
                             ffn2_pre_g, ffn2_post_g, ffn2_w_gate, ffn2_w_up, ffn2_w_down)
    y_sample = encoder_stack(x_sample, ffn1_pre_g, ffn1_post_g, ffn1_w_gate, ffn1_w_up, ffn1_w_down,
                             mix_pre_g, mix_post_g, w_in, b_gate, rpb, w_branch_a, w_branch_b, w_out,
                             ffn2_pre_g, ffn2_post_g, ffn2_w_gate, ffn2_w_up, ffn2_w_down)
    return (y_prompt, y_sample)
```

```cpp
#include <hip/hip_runtime.h>
#include <hip/hip_cooperative_groups.h>
#include <cstdio>
#include <cstdint>
namespace cg = cooperative_groups;

#define LAS __attribute__((address_space(3)))
typedef unsigned short bf16_t;
typedef short bf16x8 __attribute__((ext_vector_type(8)));
typedef short s16x4 __attribute__((ext_vector_type(4)));
typedef float f32x4 __attribute__((ext_vector_type(4)));
typedef float f32x16 __attribute__((ext_vector_type(16)));
typedef unsigned u32x4 __attribute__((ext_vector_type(4)));
typedef unsigned u32x2 __attribute__((ext_vector_type(2)));

constexpr int DM = 1024, FF = 2816, TALL = 49152, TP = 16384, TC = 16384, NCH = 3;
constexpr int INW = 5888, GOFF = 3840;
constexpr int NWAVES = 8, NTHR = 512;
constexpr float RMS_EPS = 1e-6f;
constexpr float LOG2E = 1.4426950408889634f;
constexpr float QSCALE = 0.125f * LOG2E;
constexpr float NEGBIG = -1e30f;

constexpr size_t MiB = 1u << 20;
constexpr size_t WS_WGU1 = 0, WS_WD1 = 11 * MiB, WS_WIN = 16 * MiB + MiB / 2, WS_WA = 28 * MiB, WS_WB = 28 * MiB + MiB / 2, WS_WOUT = 29 * MiB + MiB / 2,
                 WS_WGU2 = 31 * MiB + MiB / 2, WS_WD2 = 42 * MiB + MiB / 2, WS_ROPE = 48 * MiB, WS_LSE = 49 * MiB;
constexpr size_t WS_H = 50 * MiB;
constexpr size_t WS_A1 = 146 * MiB;
constexpr size_t WS_D = 410 * MiB;
constexpr size_t WS_END = 506 * MiB;
constexpr size_t WS_PROJ = 146 * MiB;
constexpr size_t WS_OG = 330 * MiB;
constexpr size_t WS_OA = 354 * MiB;
constexpr size_t WS_OB = 362 * MiB;
constexpr size_t WS_Z = 378 * MiB;

#ifndef STOP_AFTER
#define STOP_AFTER 99
#endif
#ifndef SKIP_A
#define SKIP_A 0
#endif
#ifndef SKIP_B
#define SKIP_B 0
#endif
constexpr int LDS_BYTES = 131072 + 16384;

typedef float f32x2_t __attribute__((ext_vector_type(2))); typedef __bf16 bf16x2_t __attribute__((ext_vector_type(2)));
__device__ __forceinline__ unsigned cvt_pk_bf16(float lo, float hi) { f32x2_t v = {lo, hi}; bf16x2_t b = __builtin_convertvector(v, bf16x2_t); return __builtin_bit_cast(unsigned, b); }
__device__ __forceinline__ float bf_lo(unsigned u) { return __uint_as_float(u << 16); }
__device__ __forceinline__ float bf_hi(unsigned u) { return __uint_as_float(u & 0xffff0000u); }
__device__ __forceinline__ float fexp2(float x) { return __builtin_amdgcn_exp2f(x); }
__device__ __forceinline__ float frcp(float x) { return __builtin_amdgcn_rcpf(x); }
__device__ __forceinline__ float sigmoidf_(float x) { return frcp(1.0f + fexp2(-x * LOG2E)); }
__device__ __forceinline__ float wave_sum(float v) {
#pragma unroll
    for (int o = 1; o < 64; o <<= 1) v += __shfl_xor(v, o);
    return v;
}

namespace pg8 {
constexpr int BM = 256, BK = 64, HALF = 128, HTB = HALF * BK * 2, STAGE_BYTES = 8 * HTB, NXCD = 8, WGM = 8;
__host__ __device__ __forceinline__ int lds_byte(int r, int c) { const int st = (r >> 4) * 2 + (c >> 5), rr = r & 15, cc = c & 31, ob = rr * 64 + cc * 2; return st * 1024 + (ob ^ (((ob >> 9) & 1) << 5)); }
__host__ __device__ __forceinline__ void stage_rc(int b, int& R, int& C) { const int st = b / 1024, sb = b % 1024, swz = sb ^ (((sb >> 9) & 1) << 5); R = (st >> 1) * 16 + swz / 64; C = (st & 1) * 32 + (swz % 64) / 2; }
__host__ __device__ __forceinline__ int perm32(int rho) { const int n = rho >> 4, i = rho & 15; return 8 * (i >> 2) + 4 * n + (i & 3); }

struct Unit { int pm, pn; };
struct Gemm { const bf16_t* A; const bf16_t* Bt; int M, N, K; };

struct StaticOrder {
    int nM, nN, nwg, G, c;
    __device__ void init(int M, int N, int G_, int c_) { nM = M / BM; nN = N / BM; nwg = nM * nN; G = G_; c = c_; }
    __device__ bool next(int i, Unit& u) const {
        const long L = (long)i * G + c; if (L >= nwg) return false;
        int wgid = (int)L; { const int q = nwg / NXCD, r = nwg % NXCD, xcd = wgid % NXCD, off = wgid / NXCD; wgid = (xcd < r ? xcd * (q + 1) : r * (q + 1) + (xcd - r) * q) + off; }
        const int nig = WGM * nN, gid = wgid / nig, fm = gid * WGM, gsz = (nM - fm) < WGM ? (nM - fm) : WGM;
        u.pm = fm + ((wgid % nig) % gsz); u.pn = (wgid % nig) / gsz; return true;
    }
};

template <class Epi>
__device__ __forceinline__ void gemm_phase(LAS unsigned char* lds, const Gemm g, const StaticOrder& S, const Epi& E) {
    int tid_ = threadIdx.x; asm volatile("" : "+v"(tid_));
    const int tid = tid_, wid = __builtin_amdgcn_readfirstlane(tid >> 6), lane = tid & 63, wr = wid >> 2, wc = wid & 3, fr = lane & 15, fq = lane >> 4;
    const int K = g.K, nt = K / BK;
    unsigned voffA[2], voffB[2];
#pragma unroll
    for (int i = 0; i < 2; ++i) { int R, C; stage_rc(tid * 16 + i * 8192, R, C); const int Rb = (R & ~31) + perm32(R & 31);
        voffA[i] = (unsigned)(R * K + C) * 2u; voffB[i] = (unsigned)(Rb * K + C) * 2u; }
    const size_t kstep = (size_t)(BK * 2);
    const size_t hstep = (size_t)HALF * K * 2;
    const size_t tstep = 2 * hstep;
    const unsigned ldsw = (unsigned)wid * 1024u;
    const int aoff = lds_byte(wr * 64 + fr, fq * 8), boff = lds_byte(wc * 32 + fr, fq * 8);
#define PG8_SA(b, h) (((b) * 2 + (h)) * HTB)
#define PG8_SB(b, h) ((4 + (b) * 2 + (h)) * HTB)
#define PG8_STAGE(bufoff, gbase, voff) do { _Pragma("unroll") for (int _i = 0; _i < 2; ++_i) \
        __builtin_amdgcn_global_load_lds((const __attribute__((address_space(1))) unsigned*)((const char*)(gbase) + (voff)[_i]), (LAS unsigned*)(lds + (bufoff) + ldsw + _i * 8192), 16, 0, 0); } while (0)
#define PG8_LDA(dst, b, h) do { _Pragma("unroll") for (int m = 0; m < 4; ++m) _Pragma("unroll") for (int k = 0; k < 2; ++k) dst[m][k] = *(const LAS bf16x8*)(lds + PG8_SA(b, h) + aoff + m * 2048 + k * 1024); } while (0)
#define PG8_LDB(dst, b, h) do { _Pragma("unroll") for (int n = 0; n < 2; ++n) _Pragma("unroll") for (int k = 0; k < 2; ++k) dst[n][k] = *(const LAS bf16x8*)(lds + PG8_SB(b, h) + boff + n * 2048 + k * 1024); } while (0)
#define PG8_MMA(ai, bj, At, Bt) do { __builtin_amdgcn_s_setprio(1); _Pragma("unroll") for (int m = 0; m < 4; ++m) _Pragma("unroll") for (int n = 0; n < 2; ++n) _Pragma("unroll") for (int k = 0; k < 2; ++k) \
        acc[ai][bj][m][n] = __builtin_amdgcn_mfma_f32_16x16x32_bf16(Bt[n][k], At[m][k], acc[ai][bj][m][n], 0, 0, 0); __builtin_amdgcn_s_setprio(0); } while (0)
#define PG8_WAIT_V(n) asm volatile("s_waitcnt vmcnt(" #n ")" ::: "memory")
#define PG8_WAIT_L(n) asm volatile("s_waitcnt lgkmcnt(" #n ")" ::: "memory")
#define PG8_BAR __builtin_amdgcn_s_barrier()
#define PG8_SCHED __builtin_amdgcn_sched_barrier(0)
    Unit cur, nxt; int ui = 0;
    if (!S.next(0, cur)) return;
    f32x4 acc[2][2][4][2];
#pragma unroll
    for (int a = 0; a < 2; ++a)
#pragma unroll
        for (int b = 0; b < 2; ++b)
#pragma unroll
            for (int m = 0; m < 4; ++m)
#pragma unroll
                for (int n = 0; n < 2; ++n) acc[a][b][m][n] = (f32x4){0.f, 0.f, 0.f, 0.f};
    bf16x8 At[4][2], B0[2][2], B1[2][2];
    const char* cA = (const char*)g.A + (size_t)cur.pm * tstep; const char* cB = (const char*)g.Bt + (size_t)cur.pn * tstep;
    PG8_STAGE(PG8_SB(0, 0), cB, voffB); PG8_STAGE(PG8_SB(0, 1), cB + hstep, voffB); PG8_STAGE(PG8_SA(0, 0), cA, voffA); PG8_STAGE(PG8_SA(0, 1), cA + hstep, voffA);
    if (wr == 1) PG8_BAR;
    PG8_WAIT_V(2); PG8_BAR;
    PG8_STAGE(PG8_SB(1, 0), cB + kstep, voffB); PG8_STAGE(PG8_SA(1, 0), cA + kstep, voffA); PG8_STAGE(PG8_SB(1, 1), cB + hstep + kstep, voffB);
    PG8_WAIT_V(6); PG8_BAR;
    for (;;) {
        const bool has_next = S.next(ui + 1, nxt);
        const char* nA = has_next ? (const char*)g.A + (size_t)nxt.pm * tstep : cA; const char* nB = has_next ? (const char*)g.Bt + (size_t)nxt.pn * tstep : cB;
#pragma nounroll
        for (int t = 0; t < nt; t += 2) {
            const bool last = (t == nt - 2);
            const char* a1 = cA + (size_t)(t + 1) * kstep;
            const char* a2 = last ? nA : cA + (size_t)(t + 2) * kstep; const char* b2 = last ? nB : cB + (size_t)(t + 2) * kstep;
            const char* a3 = a2 + kstep; const char* b3 = b2 + kstep;
            PG8_LDB(B0, 0, 0); PG8_LDB(B1, 0, 1); PG8_SCHED; PG8_LDA(At, 0, 0); PG8_STAGE(PG8_SA(1, 1), a1 + hstep, voffA);
            PG8_WAIT_V(8); PG8_WAIT_L(0); PG8_BAR; PG8_MMA(0, 0, At, B0); PG8_MMA(0, 1, At, B1); PG8_BAR; PG8_SCHED;
            PG8_LDA(At, 0, 1); PG8_STAGE(PG8_SB(0, 0), b2, voffB); PG8_STAGE(PG8_SB(0, 1), b2 + hstep, voffB); PG8_STAGE(PG8_SA(0, 0), a2, voffA);
            PG8_WAIT_V(8); PG8_WAIT_L(0); PG8_BAR; PG8_MMA(1, 0, At, B0); PG8_MMA(1, 1, At, B1); PG8_BAR; PG8_SCHED;
            PG8_LDB(B0, 1, 0); PG8_LDB(B1, 1, 1); PG8_SCHED; PG8_LDA(At, 1, 0); PG8_STAGE(PG8_SA(0, 1), a2 + hstep, voffA);
            PG8_WAIT_V(8); PG8_WAIT_L(0); PG8_BAR; PG8_MMA(0, 0, At, B0); PG8_MMA(0, 1, At, B1); PG8_BAR; PG8_SCHED;
            PG8_LDA(At, 1, 1); PG8_STAGE(PG8_SB(1, 0), b3, voffB); PG8_STAGE(PG8_SB(1, 1), b3 + hstep, voffB); PG8_STAGE(PG8_SA(1, 0), a3, voffA);
            PG8_WAIT_V(8); PG8_WAIT_L(0); PG8_BAR; PG8_MMA(1, 0, At, B0); PG8_MMA(1, 1, At, B1); PG8_BAR; PG8_SCHED;
        }
        if (wr == 0) PG8_BAR;
        E(acc, cur, wr, wc, fr, fq);
        if (!has_next) break;
#pragma unroll
        for (int a = 0; a < 2; ++a)
#pragma unroll
            for (int b = 0; b < 2; ++b)
#pragma unroll
                for (int m = 0; m < 4; ++m)
#pragma unroll
                    for (int n = 0; n < 2; ++n) acc[a][b][m][n] = (f32x4){0.f, 0.f, 0.f, 0.f};
        cur = nxt; cA = nA; cB = nB; ++ui;
        if (wr == 1) PG8_BAR;
    }
    PG8_WAIT_V(0);
    PG8_BAR;
#undef PG8_SA
#undef PG8_SB
#undef PG8_STAGE
#undef PG8_LDA
#undef PG8_LDB
#undef PG8_MMA
#undef PG8_WAIT_V
#undef PG8_WAIT_L
#undef PG8_BAR
#undef PG8_SCHED
}
}
using pg8::Unit;

typedef f32x4 AccT[2][2][4][2];

#define OPAQUE(o) asm volatile("" : "+v"(o))
struct EpiPlain {
    bf16_t* O; int ldc;
    __device__ __forceinline__ void operator()(const AccT& acc, const Unit& u, int wr, int wc, int fr, int fq) const {
        const unsigned lo = (unsigned)((u.pm * 256 + wr * 64 + fr) * ldc + u.pn * 256 + wc * 32 + 8 * fq) * 2u;
#pragma unroll
        for (int ai = 0; ai < 2; ++ai)
#pragma unroll
            for (int m = 0; m < 4; ++m) { unsigned o = lo + (unsigned)((ai * 128 + m * 16) * ldc) * 2u; OPAQUE(o); char* rowp = (char*)O + o;
#pragma unroll
                for (int bj = 0; bj < 2; ++bj) { const f32x4 v0 = acc[ai][bj][m][0], v1 = acc[ai][bj][m][1];
                    u32x4 w; w.x = cvt_pk_bf16(v0[0], v0[1]); w.y = cvt_pk_bf16(v0[2], v0[3]); w.z = cvt_pk_bf16(v1[0], v1[1]); w.w = cvt_pk_bf16(v1[2], v1[3]);
                    *(u32x4*)(rowp + bj * 256) = w; } }
    }
};
struct EpiSwiglu {
    bf16_t* O;
    __device__ __forceinline__ void operator()(const AccT& acc, const Unit& u, int wr, int wc, int fr, int fq) const {
        const unsigned lo = (unsigned)((u.pm * 256 + wr * 64 + fr) * FF + u.pn * 128 + wc * 32 + 8 * fq) * 2u;
#pragma unroll
        for (int ai = 0; ai < 2; ++ai)
#pragma unroll
            for (int m = 0; m < 4; ++m) { unsigned o = lo + (unsigned)((ai * 128 + m * 16) * FF) * 2u; OPAQUE(o); char* rowp = (char*)O + o;
                float r[8];
#pragma unroll
                for (int n = 0; n < 2; ++n)
#pragma unroll
                    for (int j = 0; j < 4; ++j) { const float gt = acc[ai][0][m][n][j], up = acc[ai][1][m][n][j]; r[n * 4 + j] = gt * sigmoidf_(gt) * up; }
                u32x4 w; w.x = cvt_pk_bf16(r[0], r[1]); w.y = cvt_pk_bf16(r[2], r[3]); w.z = cvt_pk_bf16(r[4], r[5]); w.w = cvt_pk_bf16(r[6], r[7]);
                *(u32x4*)rowp = w; }
    }
};
struct EpiProj {
    bf16_t* O; const float* rope; const float* bgate; int posmask;
    __device__ __forceinline__ void operator()(const AccT& acc, const Unit& u, int wr, int wc, int fr, int fq) const {
        const int pn = u.pn;
        const int row0 = u.pm * 256 + wr * 64 + fr, col0 = pn * 256 + wc * 32 + 8 * fq;
        const unsigned lo = (unsigned)(row0 * INW + col0) * 2u;
        const bool ropeTile = pn < 6, gateTile = pn >= 15;
        const float sc = (pn < 3 || pn == 9 || pn == 10) ? QSCALE : 1.0f;
        const bool rot = ropeTile && ((wc & 1) == 0) && (fq < 2);
        if (gateTile) {
#pragma unroll
            for (int bj = 0; bj < 2; ++bj) { const f32x4 b0 = *(const f32x4*)(bgate + col0 - GOFF + bj * 128), b1 = *(const f32x4*)(bgate + col0 - GOFF + bj * 128 + 4);
#pragma unroll
                for (int ai = 0; ai < 2; ++ai)
#pragma unroll
                    for (int m = 0; m < 4; ++m) { unsigned o = lo + (unsigned)((ai * 128 + m * 16) * INW) * 2u + bj * 256; OPAQUE(o);
                        f32x4 v0 = acc[ai][bj][m][0] + b0, v1 = acc[ai][bj][m][1] + b1;
#pragma unroll
                        for (int j = 0; j < 4; ++j) { v0[j] = sigmoidf_(v0[j]); v1[j] = sigmoidf_(v1[j]); }
                        u32x4 w; w.x = cvt_pk_bf16(v0[0], v0[1]); w.y = cvt_pk_bf16(v0[2], v0[3]); w.z = cvt_pk_bf16(v1[0], v1[1]); w.w = cvt_pk_bf16(v1[2], v1[3]);
                        *(u32x4*)((char*)O + o) = w; } }
        } else {
#pragma unroll
            for (int ai = 0; ai < 2; ++ai)
#pragma unroll
                for (int m = 0; m < 4; ++m) { unsigned o = lo + (unsigned)((ai * 128 + m * 16) * INW) * 2u; OPAQUE(o);
                    f32x4 cs = (f32x4){1.f, 1.f, 1.f, 1.f}, sn = (f32x4){0.f, 0.f, 0.f, 0.f};
                    if (rot) { unsigned ro = (unsigned)(((row0 + ai * 128 + m * 16) & posmask) * 16 + 4 * fq) * 4u; OPAQUE(ro); cs = *(const f32x4*)((const char*)rope + ro); sn = *(const f32x4*)((const char*)rope + ro + 32); }
#pragma unroll
                    for (int bj = 0; bj < 2; ++bj) { f32x4 v0 = acc[ai][bj][m][0], v1 = acc[ai][bj][m][1];
                        if (ropeTile) { const f32x4 x1 = v0, x2 = v1; v0 = x1 * cs - x2 * sn; v1 = x2 * cs + x1 * sn; }
                        v0 = v0 * sc; v1 = v1 * sc;
                        u32x4 w; w.x = cvt_pk_bf16(v0[0], v0[1]); w.y = cvt_pk_bf16(v0[2], v0[3]); w.z = cvt_pk_bf16(v1[0], v1[1]); w.w = cvt_pk_bf16(v1[2], v1[3]);
                        *(u32x4*)((char*)O + o + bj * 256) = w; }
                    asm volatile("" ::: "memory"); }
        }
    }
};
template <bool ADD> struct EpiGate {
    bf16_t* Z; const bf16_t* P; int goff;
    __device__ __forceinline__ void operator()(const AccT& acc, const Unit& u, int wr, int wc, int fr, int fq) const {
        const int row0 = u.pm * 256 + wr * 64 + fr, col0 = u.pn * 256 + wc * 32 + 8 * fq;
        const unsigned zl = (unsigned)(row0 * DM + col0) * 2u, gl = (unsigned)(row0 * INW + goff + col0) * 2u;
#pragma unroll
        for (int ai = 0; ai < 2; ++ai)
#pragma unroll
            for (int m = 0; m < 4; ++m) {
                unsigned zo_ = zl + (unsigned)((ai * 128 + m * 16) * DM) * 2u, go_ = gl + (unsigned)((ai * 128 + m * 16) * INW) * 2u; OPAQUE(zo_); OPAQUE(go_);
                char* zp = (char*)Z + zo_; const char* gp = (const char*)P + go_;
#pragma unroll
                for (int bj = 0; bj < 2; ++bj) { const f32x4 v0 = acc[ai][bj][m][0], v1 = acc[ai][bj][m][1];
                    const u32x4 gw = *(const u32x4*)(gp + bj * 256);
                    float r[8];
                    r[0] = bf_lo(gw.x) * v0[0]; r[1] = bf_hi(gw.x) * v0[1]; r[2] = bf_lo(gw.y) * v0[2]; r[3] = bf_hi(gw.y) * v0[3];
                    r[4] = bf_lo(gw.z) * v1[0]; r[5] = bf_hi(gw.z) * v1[1]; r[6] = bf_lo(gw.w) * v1[2]; r[7] = bf_hi(gw.w) * v1[3];
                    if (ADD) { const u32x4 zo = *(const u32x4*)(zp + bj * 256);
                        r[0] += bf_lo(zo.x); r[1] += bf_hi(zo.x); r[2] += bf_lo(zo.y); r[3] += bf_hi(zo.y); r[4] += bf_lo(zo.z); r[5] += bf_hi(zo.z); r[6] += bf_lo(zo.w); r[7] += bf_hi(zo.w); }
                    u32x4 w; w.x = cvt_pk_bf16(r[0], r[1]); w.y = cvt_pk_bf16(r[2], r[3]); w.z = cvt_pk_bf16(r[4], r[5]); w.w = cvt_pk_bf16(r[6], r[7]);
                    *(u32x4*)(zp + bj * 256) = w; }
                asm volatile("" ::: "memory"); }
    }
};

struct Args {
    const float* in[20];
    float* out;
    unsigned char* ws;
};

__device__ __forceinline__ void transpose_item(const float* W, int ldw, int sc, bf16_t* WT, int K, int n0, int k0, LAS float* scr, int lane) {
#pragma unroll 8
    for (int i = 0; i < 32; ++i) { const int kk = 2 * i + (lane >> 5); scr[kk * 33 + (lane & 31)] = W[(size_t)(k0 + kk) * ldw + sc]; }
    asm volatile("s_waitcnt lgkmcnt(0)" ::: "memory");
    const int c = lane & 7;
#pragma unroll
    for (int j = 0; j < 4; ++j) { const int n = (lane >> 3) + 8 * j; const LAS float* s = scr + (8 * c) * 33 + n;
        u32x4 o; o.x = cvt_pk_bf16(s[0 * 33], s[1 * 33]); o.y = cvt_pk_bf16(s[2 * 33], s[3 * 33]); o.z = cvt_pk_bf16(s[4 * 33], s[5 * 33]); o.w = cvt_pk_bf16(s[6 * 33], s[7 * 33]);
        *(u32x4*)(WT + (size_t)(n0 + n) * K + k0 + 8 * c) = o; }
    asm volatile("s_waitcnt lgkmcnt(0)" ::: "memory");
}
template <int KIND>
__device__ __forceinline__ void transpose_items(const float* W0, const float* W1, int ldw, bf16_t* WT, int K, int N, LAS float* scr, int lane, int gw, int NGW) {
    const int nblk = N / 32, nitems = (K / 64) * nblk;
    for (int it = gw; it < nitems; it += NGW) {
        const int kb = it / nblk, nb = it % nblk, n0 = nb * 32, n = n0 + (lane & 31);
        const float* W = W0; int sc = n;
        if (KIND == 1) { const int tile = n >> 8, bj = (n >> 7) & 1, j = n & 127; W = bj ? W1 : W0; sc = tile * 128 + j; }
        if (KIND == 2) { if (n < 1536 && (n & 63) < 16) { const int p = n & 15; const int d = (p < 8) ? ((p & 3) + ((p >> 2) << 3)) : (4 + (p & 3) + (((p - 8) >> 2) << 3)); sc = (n & ~15) + d; } }
        transpose_item(W, ldw, sc, WT, K, n0, kb * 64, scr, lane);
    }
}

template <bool HAS_D, bool HAS_H>
__device__ __forceinline__ void row_pass(const float* xa, const float* xb, const bf16_t* D, const float* gpost, float dscale, float* xout, const float* gpre, bf16_t* hout, int lane, int gw, int NGW) {
    f32x4 gp[4], gq[4];
#pragma unroll
    for (int j = 0; j < 4; ++j) { if (HAS_D) gp[j] = *(const f32x4*)(gpost + 4 * lane + 256 * j); if (HAS_H) gq[j] = *(const f32x4*)(gpre + 4 * lane + 256 * j); }
    for (int row = gw; row < TALL; row += NGW) {
        const float* xr = (row < TP) ? xa + (size_t)row * DM : xb + (size_t)(row - TP) * DM;
        f32x4 v[4];
#pragma unroll
        for (int j = 0; j < 4; ++j) v[j] = *(const f32x4*)(xr + 4 * lane + 256 * j);
        if (HAS_D) {
            f32x4 d[4]; float ss = 0.f;
#pragma unroll
            for (int j = 0; j < 4; ++j) { const u32x2 w = *(const u32x2*)(D + (size_t)row * DM + 4 * lane + 256 * j);
                d[j] = (f32x4){bf_lo(w.x), bf_hi(w.x), bf_lo(w.y), bf_hi(w.y)}; ss += (d[j][0] * d[j][0] + d[j][1] * d[j][1]) + (d[j][2] * d[j][2] + d[j][3] * d[j][3]); }
            const float r = dscale * __builtin_amdgcn_rsqf(wave_sum(ss) * (1.0f / DM) + RMS_EPS);
#pragma unroll
            for (int j = 0; j < 4; ++j) { v[j] = v[j] + d[j] * gp[j] * r; *(f32x4*)(xout + (size_t)row * DM + 4 * lane + 256 * j) = v[j]; }
        }
        if (HAS_H) {
            float ss = 0.f;
#pragma unroll
            for (int j = 0; j < 4; ++j) ss += (v[j][0] * v[j][0] + v[j][1] * v[j][1]) + (v[j][2] * v[j][2] + v[j][3] * v[j][3]);
            const float r = __builtin_amdgcn_rsqf(wave_sum(ss) * (1.0f / DM) + RMS_EPS);
#pragma unroll
            for (int j = 0; j < 4; ++j) { const f32x4 o = v[j] * gq[j] * r; u32x2 w; w.x = cvt_pk_bf16(o[0], o[1]); w.y = cvt_pk_bf16(o[2], o[3]);
                *(u32x2*)(hout + (size_t)row * DM + 4 * lane + 256 * j) = w; }
        }
    }
}

constexpr int KS = 144;
constexpr int WAVE_LDS = 2 * 32 * KS;
constexpr int RPB_OFF = 81920;
__device__ __forceinline__ int crow(int r, int hi) { return (r & 3) + 8 * (r >> 2) + 4 * hi; }
__device__ __forceinline__ s16x4 vtr(LAS const unsigned char* p) { return __builtin_bit_cast(s16x4, __builtin_amdgcn_ds_read_tr16_b64_v4i16((LAS s16x4*)p)); }

struct KVRegs { u32x4 k[4], v[4]; };

#define ATT_LOAD(R, tokexpr) do { _Pragma("unroll") for (int _i = 0; _i < 4; ++_i) { const int _rowi = (lane >> 3) + 8 * _i; const size_t _tok = (size_t)(tokexpr); \
        const bf16_t* _p = proj + _tok * INW + 8 * (lane & 7); R.k[_i] = *(const u32x4*)(_p + kcol); R.v[_i] = *(const u32x4*)(_p + vcol); } } while (0)
#define ATT_STORE(R) do { _Pragma("unroll") for (int _i = 0; _i < 4; ++_i) { const int _rowi = (lane >> 3) + 8 * _i; \
        *(LAS u32x4*)(wl + _rowi * KS + 16 * (lane & 7)) = R.k[_i]; *(LAS u32x4*)(wl + 32 * KS + _rowi * KS + 16 * (lane & 7)) = R.v[_i]; } } while (0)
#define ATT_QK(s) do { s = (f32x16){0.f,0.f,0.f,0.f,0.f,0.f,0.f,0.f,0.f,0.f,0.f,0.f,0.f,0.f,0.f,0.f}; _Pragma("unroll") for (int _d = 0; _d < 4; ++_d) { \
        const bf16x8 _kf = *(const LAS bf16x8*)(wl + q32 * KS + 32 * _d + 16 * hi); s = __builtin_amdgcn_mfma_f32_32x32x16_bf16(_kf, qr[_d], s, 0, 0, 0); } } while (0)
#define ATT_SOFTMAX_PV(s) do { \
        float _tm = s[0]; _Pragma("unroll") for (int _r = 1; _r < 16; ++_r) _tm = fmaxf(_tm, s[_r]); \
        _tm = fmaxf(_tm, __shfl_xor(_tm, 32)); \
        const float _mn = fmaxf(m_run, _tm), _al = fexp2(m_run - _mn); m_run = _mn; \
        float _sum = 0.f; _Pragma("unroll") for (int _r = 0; _r < 16; ++_r) { s[_r] = fexp2(s[_r] - _mn); _sum += s[_r]; } \
        l_run = l_run * _al + _sum; \
        _Pragma("unroll") for (int _r = 0; _r < 16; ++_r) { oT0[_r] *= _al; oT1[_r] *= _al; } \
        u32x4 _p0, _p1; _p0.x = cvt_pk_bf16(s[0], s[1]); _p0.y = cvt_pk_bf16(s[2], s[3]); _p0.z = cvt_pk_bf16(s[4], s[5]); _p0.w = cvt_pk_bf16(s[6], s[7]); \
        _p1.x = cvt_pk_bf16(s[8], s[9]); _p1.y = cvt_pk_bf16(s[10], s[11]); _p1.z = cvt_pk_bf16(s[12], s[13]); _p1.w = cvt_pk_bf16(s[14], s[15]); \
        const bf16x8 _pb0 = __builtin_bit_cast(bf16x8, _p0), _pb1 = __builtin_bit_cast(bf16x8, _p1); \
        { const s16x4 a = vtr(vtb), b = vtr(vtb + 8 * KS); const bf16x8 vf = (bf16x8){a[0], a[1], a[2], a[3], b[0], b[1], b[2], b[3]}; oT0 = __builtin_amdgcn_mfma_f32_32x32x16_bf16(vf, _pb0, oT0, 0, 0, 0); } \
        { const s16x4 a = vtr(vtb + 16 * KS), b = vtr(vtb + 24 * KS); const bf16x8 vf = (bf16x8){a[0], a[1], a[2], a[3], b[0], b[1], b[2], b[3]}; oT0 = __builtin_amdgcn_mfma_f32_32x32x16_bf16(vf, _pb1, oT0, 0, 0, 0); } \
        { const s16x4 a = vtr(vtb + 64), b = vtr(vtb + 64 + 8 * KS); const bf16x8 vf = (bf16x8){a[0], a[1], a[2], a[3], b[0], b[1], b[2], b[3]}; oT1 = __builtin_amdgcn_mfma_f32_32x32x16_bf16(vf, _pb0, oT1, 0, 0, 0); } \
        { const s16x4 a = vtr(vtb + 64 + 16 * KS), b = vtr(vtb + 64 + 24 * KS); const bf16x8 vf = (bf16x8){a[0], a[1], a[2], a[3], b[0], b[1], b[2], b[3]}; oT1 = __builtin_amdgcn_mfma_f32_32x32x16_bf16(vf, _pb1, oT1, 0, 0, 0); } \
    } while (0)
#define ATT_WRITE_O(orow) do { \
        _Pragma("unroll") for (int _g = 0; _g < 4; ++_g) { \
            u32x2 w0, w1; w0.x = cvt_pk_bf16(oT0[4 * _g] * inv, oT0[4 * _g + 1] * inv); w0.y = cvt_pk_bf16(oT0[4 * _g + 2] * inv, oT0[4 * _g + 3] * inv); \
            w1.x = cvt_pk_bf16(oT1[4 * _g] * inv, oT1[4 * _g + 1] * inv); w1.y = cvt_pk_bf16(oT1[4 * _g + 2] * inv, oT1[4 * _g + 3] * inv); \
            *(u32x2*)((orow) + 8 * _g + 4 * hi) = w0; *(u32x2*)((orow) + 32 + 8 * _g + 4 * hi) = w1; } } while (0)

__device__ __forceinline__ void attnA_unit(int u, const bf16_t* proj, bf16_t* og, float* lse, int S, LAS unsigned char* wl, int lane) {
    const int q32 = lane & 31, hi = lane >> 5;
    const int g = u / 2048, rem = u % 2048, h = rem / 512, idx = rem % 512;
    const int per_seq = S / 32, seq = idx / per_seq, ii = idx % per_seq;
    const int dsh = 2 * g, dl = 1 << dsh;
    const int r = ii & (dl - 1), c = ii >> dsh, L = S >> dsh;
    const int hd = 4 * g + h, qcol = hd * 64, kcol = 768 + hd * 64, vcol = 1536 + hd * 64;
    const size_t seqbase = (size_t)seq * S;
    const int qm = 32 * c + q32;
    const size_t qtok = seqbase + (size_t)qm * dl + r;
    bf16x8 qr[4];
#pragma unroll
    for (int d = 0; d < 4; ++d) qr[d] = *(const bf16x8*)(proj + qtok * INW + qcol + 16 * d + 8 * hi);
    const int m0 = 32 * c - 64;
    LAS const unsigned char* vtb = wl + 32 * KS + (4 * hi + ((lane & 15) >> 2)) * KS + (16 * ((lane >> 4) & 1) + 4 * (lane & 3)) * 2;
    float m_run = -1e29f, l_run = 0.f;
    f32x16 oT0 = (f32x16){0.f,0.f,0.f,0.f,0.f,0.f,0.f,0.f,0.f,0.f,0.f,0.f,0.f,0.f,0.f,0.f}, oT1 = oT0;
    KVRegs R;
#define TOKA(t) (seqbase + (size_t)min(max(m0 + 32 * (t) + _rowi, 0), L - 1) * dl + r)
    ATT_LOAD(R, TOKA(0));
    for (int t = 0; t < 5; ++t) {
        ATT_STORE(R);
        if (t < 4) { ATT_LOAD(R, TOKA(t + 1)); }
        f32x16 s; ATT_QK(s);
#pragma unroll
        for (int rr = 0; rr < 16; ++rr) { const int km = m0 + 32 * t + crow(rr, hi); const int dk = km - qm;
            const bool ok = (km >= 0) && (km < L) && (dk <= 64) && (dk >= -64); s[rr] = ok ? s[rr] : NEGBIG; }
        ATT_SOFTMAX_PV(s);
    }
#undef TOKA
    const float lt = l_run + __shfl_xor(l_run, 32);
    const float inv = frcp(lt);
    bf16_t* orow = og + qtok * 768 + hd * 64;
    ATT_WRITE_O(orow);
    if (hi == 0) lse[qtok * 12 + hd] = m_run + __builtin_amdgcn_logf(lt);
}

__device__ __forceinline__ void attnB_unit(int u, const bf16_t* proj, bf16_t* ob, int S, LAS unsigned char* wl, LAS const float* rpbL, int lane) {
    const int q32 = lane & 31, hi = lane >> 5;
    const int h = u / 512, idx = u % 512;
    const int per_seq = S / 32, seq = idx / per_seq, ii = idx % per_seq;
    const int rp = ii >> 2, cc = ii & 3, rows = S / 64;
    const int ri0 = 2 * rp, qrow = ri0 + (q32 >> 4), qcolg = 16 * cc + (q32 & 15);
    const int qcol = 2304 + h * 64, kcol = 2816 + h * 64, vcol = 3328 + h * 64;
    const size_t seqbase = (size_t)seq * S;
    const size_t qtok = seqbase + (size_t)qrow * 64 + qcolg;
    bf16x8 qr[4];
#pragma unroll
    for (int d = 0; d < 4; ++d) qr[d] = *(const bf16x8*)(proj + qtok * INW + qcol + 16 * d + 8 * hi);
    const int w0 = (cc == 0) ? 0 : (cc == 1) ? 8 : (cc == 2) ? 24 : 32;
    const int rs0 = min(max(ri0 - 4, 0), rows - 8), rs1 = min(max(ri0 - 3, 0), rows - 8);
    const int ntile = rs1 + 8 - rs0;
    const int rsq = min(max(qrow - 4, 0), rows - 8), csq = min(max(qcolg - 8, 0), 48);
    LAS const unsigned char* vtb = wl + 32 * KS + (4 * hi + ((lane & 15) >> 2)) * KS + (16 * ((lane >> 4) & 1) + 4 * (lane & 3)) * 2;
    LAS const float* rb = rpbL + h * 465;
    float m_run = -1e29f, l_run = 0.f;
    f32x16 oT0 = (f32x16){0.f,0.f,0.f,0.f,0.f,0.f,0.f,0.f,0.f,0.f,0.f,0.f,0.f,0.f,0.f,0.f}, oT1 = oT0;
    KVRegs R;
#define TOKB(t) (seqbase + (size_t)(rs0 + (t)) * 64 + w0 + _rowi)
    ATT_LOAD(R, TOKB(0));
    for (int t = 0; t < ntile; ++t) {
        ATT_STORE(R);
        if (t + 1 < ntile) { ATT_LOAD(R, TOKB(t + 1)); }
        f32x16 s; ATT_QK(s);
        const int kr = rs0 + t;
        const bool rowok = (kr >= rsq) && (kr < rsq + 8);
        const int bi0 = (kr - qrow + 7) * 31 + (w0 - qcolg + 15);
#pragma unroll
        for (int rr = 0; rr < 16; ++rr) { const int kv = crow(rr, hi); const int ck = w0 + kv;
            const bool ok = rowok && (ck >= csq) && (ck < csq + 16);
            const int bi = min(max(bi0 + kv, 0), 464);
            s[rr] = ok ? s[rr] + rb[bi] : NEGBIG; }
        ATT_SOFTMAX_PV(s);
    }
#undef TOKB
    const float lt = l_run + __shfl_xor(l_run, 32);
    const float inv = frcp(lt);
    bf16_t* orow = ob + qtok * 512 + h * 64;
    ATT_WRITE_O(orow);
}

#define GSYNC() do { asm volatile("s_waitcnt vmcnt(0) lgkmcnt(0)" ::: "memory"); grid.sync(); __builtin_amdgcn_fence(__ATOMIC_ACQUIRE, "agent"); asm volatile("s_waitcnt vmcnt(0)" ::: "memory"); } while (0)

template <int CH>
__device__ __forceinline__ void mixer_chunk(cg::grid_group& grid, LAS unsigned char* lds, int G, int gw, int NGW, const bf16_t* H, const bf16_t* Win, const bf16_t* Wa, const bf16_t* Wb, const bf16_t* Wout,
        bf16_t* proj, bf16_t* og, float* lse, bf16_t* oa, bf16_t* ob, bf16_t* Z, bf16_t* Dbuf, const float* rope, const float* bgate, const float* rpb) {
    int tid_ = threadIdx.x; asm volatile("" : "+v"(tid_));
    const int tid = tid_, lane = tid & 63, wid = __builtin_amdgcn_readfirstlane(tid >> 6);
    pg8::StaticOrder SO;

        constexpr int ch = CH; constexpr int S = (CH == 0) ? 8192 : 16384;
        const bf16_t* Hc = H + (size_t)ch * TC * DM;
        { pg8::Gemm g{Hc, Win, TC, INW, DM}; SO.init(TC, INW, G, blockIdx.x); EpiProj E{proj, rope, bgate, S - 1}; pg8::gemm_phase(lds, g, SO, E); }
        GSYNC();
        {
            LAS unsigned char* wl = lds + wid * WAVE_LDS;
            for (int u = gw; u < 3 * 4 * (TC / 32); u += NGW) { if (!SKIP_A) attnA_unit(u, proj, og, lse, S, wl, lane); }
        }
        GSYNC();
        {
            LAS float* rpbL = (LAS float*)(lds + RPB_OFF);
            for (int i = tid; i < 8 * 465; i += NTHR) rpbL[i] = rpb[i] * LOG2E;
            __syncthreads();
            LAS unsigned char* wl = lds + wid * WAVE_LDS;
            for (int u = gw; u < 8 * (TC / 32); u += NGW) { if (!SKIP_B) attnB_unit(u, proj, ob, S, wl, rpbL, lane); }
            for (int i = blockIdx.x * NTHR + tid; i < TC * 32; i += G * NTHR) {
                const int tl = i >> 5, h = (i >> 3) & 3, c8 = i & 7;
                const float l0 = lse[tl * 12 + h], l1 = lse[tl * 12 + 4 + h], l2 = lse[tl * 12 + 8 + h];
                const float mx = fmaxf(l0, fmaxf(l1, l2));
                float e0 = fexp2(l0 - mx), e1 = fexp2(l1 - mx), e2 = fexp2(l2 - mx);
                const float is = frcp(e0 + e1 + e2); e0 *= is; e1 *= is; e2 *= is;
                const bf16_t* p = og + (size_t)tl * 768 + h * 64 + c8 * 8;
                const u32x4 v0 = *(const u32x4*)p, v1 = *(const u32x4*)(p + 256), v2 = *(const u32x4*)(p + 512);
                u32x4 w;
                w.x = cvt_pk_bf16(e0 * bf_lo(v0.x) + e1 * bf_lo(v1.x) + e2 * bf_lo(v2.x), e0 * bf_hi(v0.x) + e1 * bf_hi(v1.x) + e2 * bf_hi(v2.x));
                w.y = cvt_pk_bf16(e0 * bf_lo(v0.y) + e1 * bf_lo(v1.y) + e2 * bf_lo(v2.y), e0 * bf_hi(v0.y) + e1 * bf_hi(v1.y) + e2 * bf_hi(v2.y));
                w.z = cvt_pk_bf16(e0 * bf_lo(v0.z) + e1 * bf_lo(v1.z) + e2 * bf_lo(v2.z), e0 * bf_hi(v0.z) + e1 * bf_hi(v1.z) + e2 * bf_hi(v2.z));
                w.w = cvt_pk_bf16(e0 * bf_lo(v0.w) + e1 * bf_lo(v1.w) + e2 * bf_lo(v2.w), e0 * bf_hi(v0.w) + e1 * bf_hi(v1.w) + e2 * bf_hi(v2.w));
                *(u32x4*)(oa + (size_t)tl * 256 + h * 64 + c8 * 8) = w;
            }
        }
        GSYNC();
        { pg8::Gemm g{oa, Wa, TC, DM, 256}; SO.init(TC, DM, G, blockIdx.x); EpiGate<false> E{Z, proj, GOFF}; pg8::gemm_phase(lds, g, SO, E); }
        { pg8::Gemm g{ob, Wb, TC, DM, 512}; SO.init(TC, DM, G, blockIdx.x); EpiGate<true> E{Z, proj, GOFF + DM}; pg8::gemm_phase(lds, g, SO, E); }
        GSYNC();
        { pg8::Gemm g{Z, Wout, TC, DM, DM}; SO.init(TC, DM, G, blockIdx.x); EpiPlain E{Dbuf + (size_t)ch * TC * DM, DM}; pg8::gemm_phase(lds, g, SO, E); }

}

__global__ void __launch_bounds__(NTHR, 2) enc_fwd(Args a) {
    extern __shared__ __attribute__((aligned(16))) unsigned char lds_raw[];
    LAS unsigned char* lds = (LAS unsigned char*)lds_raw;
    cg::grid_group grid = cg::this_grid();
    const int tid = threadIdx.x, lane = tid & 63, wid = __builtin_amdgcn_readfirstlane(tid >> 6);
    const int G = gridDim.x, gw = blockIdx.x * NWAVES + wid, NGW = G * NWAVES;
    unsigned char* ws = a.ws;
    const float* x_p = a.in[0]; const float* x_s = a.in[1];
    bf16_t* Wgu1 = (bf16_t*)(ws + WS_WGU1); bf16_t* Wd1 = (bf16_t*)(ws + WS_WD1); bf16_t* Win = (bf16_t*)(ws + WS_WIN);
    bf16_t* Wa = (bf16_t*)(ws + WS_WA); bf16_t* Wb = (bf16_t*)(ws + WS_WB); bf16_t* Wout = (bf16_t*)(ws + WS_WOUT);
    bf16_t* Wgu2 = (bf16_t*)(ws + WS_WGU2); bf16_t* Wd2 = (bf16_t*)(ws + WS_WD2);
    float* rope = (float*)(ws + WS_ROPE); float* lse = (float*)(ws + WS_LSE);
    bf16_t* H = (bf16_t*)(ws + WS_H); bf16_t* A1 = (bf16_t*)(ws + WS_A1); bf16_t* Dbuf = (bf16_t*)(ws + WS_D);
    bf16_t* proj = (bf16_t*)(ws + WS_PROJ); bf16_t* og = (bf16_t*)(ws + WS_OG); bf16_t* oa = (bf16_t*)(ws + WS_OA); bf16_t* ob = (bf16_t*)(ws + WS_OB); bf16_t* Z = (bf16_t*)(ws + WS_Z);
    float* out = a.out;

    {
        LAS float* scr = (LAS float*)(lds + wid * 16384);
        transpose_items<1>(a.in[4], a.in[5], FF, Wgu1, DM, 2 * FF, scr, lane, gw, NGW);
        transpose_items<0>(a.in[6], nullptr, DM, Wd1, FF, DM, scr, lane, gw, NGW);
        transpose_items<2>(a.in[9], nullptr, INW, Win, DM, INW, scr, lane, gw, NGW);
        transpose_items<0>(a.in[12], nullptr, DM, Wa, 256, DM, scr, lane, gw, NGW);
        transpose_items<0>(a.in[13], nullptr, DM, Wb, 512, DM, scr, lane, gw, NGW);
        transpose_items<0>(a.in[14], nullptr, DM, Wout, DM, DM, scr, lane, gw, NGW);
        transpose_items<1>(a.in[17], a.in[18], FF, Wgu2, DM, 2 * FF, scr, lane, gw, NGW);
        transpose_items<0>(a.in[19], nullptr, DM, Wd2, FF, DM, scr, lane, gw, NGW);
        for (int i = blockIdx.x * NTHR + tid; i < 16384 * 8; i += G * NTHR) {
            const int pos = i >> 3, f = i & 7;
            const double invf = (f == 0) ? 1.0 : (f == 1) ? 0.19392274474868576 : (f == 2) ? 0.03760603093086393 : (f == 3) ? 0.007292664737217109 : (f == 4) ? 0.001414213562373095
                              : (f == 5) ? 0.0002742481756762073 : (f == 6) ? 5.318295896944988e-05 : 1.031338537721246e-05;
            const float angf = (float)pos * (float)invf;
            double tt = (double)angf * 0.15915494309189535; tt -= floor(tt);
            const float fr = (float)tt;
            rope[pos * 16 + f] = __builtin_amdgcn_cosf(fr); rope[pos * 16 + 8 + f] = __builtin_amdgcn_sinf(fr);
        }
        row_pass<false, true>(x_p, x_s, nullptr, nullptr, 0.f, nullptr, a.in[2], H, lane, gw, NGW);
    }
    GSYNC();
    pg8::StaticOrder SO;
    { pg8::Gemm g{H, Wgu1, TALL, 2 * FF, DM}; SO.init(TALL, 2 * FF, G, blockIdx.x); EpiSwiglu E{A1}; pg8::gemm_phase(lds, g, SO, E); }
    GSYNC();
    { pg8::Gemm g{A1, Wd1, TALL, DM, FF}; SO.init(TALL, DM, G, blockIdx.x); EpiPlain E{Dbuf, DM}; pg8::gemm_phase(lds, g, SO, E); }
    GSYNC();
    row_pass<true, true>(x_p, x_s, Dbuf, a.in[3], 0.5f, out, a.in[7], H, lane, gw, NGW);
    GSYNC();
    if (STOP_AFTER <= 1) return;
    if (STOP_AFTER <= 1) return;
    mixer_chunk<0>(grid, lds, G, gw, NGW, H, Win, Wa, Wb, Wout, proj, og, lse, oa, ob, Z, Dbuf, rope, a.in[10], a.in[11]);
    mixer_chunk<1>(grid, lds, G, gw, NGW, H, Win, Wa, Wb, Wout, proj, og, lse, oa, ob, Z, Dbuf, rope, a.in[10], a.in[11]);
    mixer_chunk<2>(grid, lds, G, gw, NGW, H, Win, Wa, Wb, Wout, proj, og, lse, oa, ob, Z, Dbuf, rope, a.in[10], a.in[11]);
    GSYNC();
    row_pass<true, true>(out, out + (size_t)TP * DM, Dbuf, a.in[8], 1.0f, out, a.in[15], H, lane, gw, NGW);
    GSYNC();
    if (STOP_AFTER <= 2) return;
    if (STOP_AFTER <= 2) return;
    { pg8::Gemm g{H, Wgu2, TALL, 2 * FF, DM}; SO.init(TALL, 2 * FF, G, blockIdx.x); EpiSwiglu E{A1}; pg8::gemm_phase(lds, g, SO, E); }
    GSYNC();
    { pg8::Gemm g{A1, Wd2, TALL, DM, FF}; SO.init(TALL, DM, G, blockIdx.x); EpiPlain E{Dbuf, DM}; pg8::gemm_phase(lds, g, SO, E); }
    GSYNC();
    row_pass<true, false>(out, out + (size_t)TP * DM, Dbuf, a.in[16], 0.5f, out, nullptr, nullptr, lane, gw, NGW);
}

extern "C" void kernel_launch(void* const* d_in, const int* in_sizes, int n_in, void* d_out, int out_size, void* d_ws, size_t ws_size, hipStream_t stream) {
    static int grid = 0;
    if (grid == 0) {
        if (n_in != 20 || out_size != TALL * DM || ws_size < WS_END) { fprintf(stderr, "kernel_launch: unexpected shapes (n_in %d out %d ws %zu)\n", n_in, out_size, ws_size); grid = -1; return; }
        int dev = 0, cus = 0, per_cu = 0;
        hipGetDevice(&dev);
        hipDeviceGetAttribute(&cus, hipDeviceAttributeMultiprocessorCount, dev);
        hipFuncSetAttribute((const void*)enc_fwd, hipFuncAttributeMaxDynamicSharedMemorySize, LDS_BYTES);
        hipOccupancyMaxActiveBlocksPerMultiprocessor(&per_cu, (const void*)enc_fwd, NTHR, LDS_BYTES);
        if (per_cu < 1) per_cu = 1;
        grid = cus * per_cu;
        (void)hipGetLastError();
    }
    if (grid < 0) return;
    Args a{};
    for (int i = 0; i < 20; ++i) a.in[i] = (const float*)d_in[i];
    a.out = (float*)d_out; a.ws = (unsigned char*)d_ws;
    void* args[] = {&a};
    hipError_t e = hipLaunchCooperativeKernel((const void*)enc_fwd, dim3(grid), dim3(NTHR), args, LDS_BYTES, stream);
    if (e != hipSuccess) fprintf(stderr, "cooperative launch failed: %s (grid %d)\n", hipGetErrorString(e), grid);
}
```

```cpp
#include <hip/hip_runtime.h>
#include <hip/hip_cooperative_groups.h>
#include <cstdio>
#include <cstdint>
namespace cg = cooperative_groups;

#define LAS __attribute__((address_space(3)))
typedef unsigned short bf16_t;
typedef short bf16x8 __attribute__((ext_vector_type(8)));
typedef short s16x4 __attribute__((ext_vector_type(4)));
typedef float f32x4 __attribute__((ext_vector_type(4)));
typedef float f32x16 __attribute__((ext_vector_type(16)));
typedef unsigned u32x4 __attribute__((ext_vector_type(4)));
typedef unsigned u32x2 __attribute__((ext_vector_type(2)));

constexpr int DM = 1024, FF = 2816, TALL = 49152, TP = 16384, TC = 16384, NCH = 3;
constexpr int INW = 5888, GOFF = 3840;
constexpr int NWAVES = 8, NTHR = 512;
constexpr float RMS_EPS = 1e-6f;
constexpr float LOG2E = 1.4426950408889634f;
constexpr float QSCALE = 0.125f * LOG2E;
constexpr float NEGBIG = -1e30f;

constexpr size_t MiB = 1u << 20;
constexpr size_t WS_WGU1 = 0, WS_WD1 = 11 * MiB, WS_WIN = 16 * MiB + MiB / 2, WS_WA = 28 * MiB, WS_WB = 28 * MiB + MiB / 2, WS_WOUT = 29 * MiB + MiB / 2,
                 WS_WGU2 = 31 * MiB + MiB / 2, WS_WD2 = 42 * MiB + MiB / 2, WS_ROPE = 48 * MiB, WS_LSE = 49 * MiB;
constexpr size_t WS_H = 50 * MiB;
constexpr size_t WS_A1 = 146 * MiB;
constexpr size_t WS_D = 410 * MiB;
constexpr size_t WS_BAR = 506 * MiB;
constexpr size_t WS_END = 507 * MiB;
constexpr size_t WS_PROJ = 146 * MiB;
constexpr size_t WS_OG = 330 * MiB;
constexpr size_t WS_OA = 354 * MiB;
constexpr size_t WS_OB = 362 * MiB;
constexpr size_t WS_Z = 378 * MiB;

#ifndef STOP_AFTER
#define STOP_AFTER 99
#endif
#ifndef SKIP_A
#define SKIP_A 0
#endif
#ifndef SKIP_B
#define SKIP_B 0
#endif
constexpr int LDS_BYTES = 131072 + 16384;

typedef float f32x2_t __attribute__((ext_vector_type(2))); typedef __bf16 bf16x2_t __attribute__((ext_vector_type(2)));
__device__ __forceinline__ unsigned cvt_pk_bf16(float lo, float hi) { f32x2_t v = {lo, hi}; bf16x2_t b = __builtin_convertvector(v, bf16x2_t); return __builtin_bit_cast(unsigned, b); }
__device__ __forceinline__ float bf_lo(unsigned u) { return __uint_as_float(u << 16); }
__device__ __forceinline__ float bf_hi(unsigned u) { return __uint_as_float(u & 0xffff0000u); }
__device__ __forceinline__ float fexp2(float x) { return __builtin_amdgcn_exp2f(x); }
__device__ __forceinline__ float frcp(float x) { return __builtin_amdgcn_rcpf(x); }
__device__ __forceinline__ float sigmoidf_(float x) { return frcp(1.0f + fexp2(-x * LOG2E)); }
__device__ __forceinline__ float wave_sum(float v) {
#pragma unroll
    for (int o = 1; o < 64; o <<= 1) v += __shfl_xor(v, o);
    return v;
}

namespace pg8 {
constexpr int BM = 256, BK = 64, HALF = 128, HTB = HALF * BK * 2, STAGE_BYTES = 8 * HTB, NXCD = 8, WGM = 8;
__host__ __device__ __forceinline__ int lds_byte(int r, int c) { const int st = (r >> 4) * 2 + (c >> 5), rr = r & 15, cc = c & 31, ob = rr * 64 + cc * 2; return st * 1024 + (ob ^ (((ob >> 9) & 1) << 5)); }
__host__ __device__ __forceinline__ void stage_rc(int b, int& R, int& C) { const int st = b / 1024, sb = b % 1024, swz = sb ^ (((sb >> 9) & 1) << 5); R = (st >> 1) * 16 + swz / 64; C = (st & 1) * 32 + (swz % 64) / 2; }
__host__ __device__ __forceinline__ int perm32(int rho) { const int n = rho >> 4, i = rho & 15; return 8 * (i >> 2) + 4 * n + (i & 3); }

struct Unit { int pm, pn; };
struct Gemm { const bf16_t* A; const bf16_t* Bt; int M, N, K; };

struct StaticOrder {
    int nM, nN, nwg, G, c;
    __device__ void init(int M, int N, int G_, int c_) { nM = M / BM; nN = N / BM; nwg = nM * nN; G = G_; c = c_; }
    __device__ bool next(int i, Unit& u) const {
        const long L = (long)i * G + c; if (L >= nwg) return false;
        int wgid = (int)L; { const int q = nwg / NXCD, r = nwg % NXCD, xcd = wgid % NXCD, off = wgid / NXCD; wgid = (xcd < r ? xcd * (q + 1) : r * (q + 1) + (xcd - r) * q) + off; }
        const int nig = WGM * nN, gid = wgid / nig, fm = gid * WGM, gsz = (nM - fm) < WGM ? (nM - fm) : WGM;
        u.pm = fm + ((wgid % nig) % gsz); u.pn = (wgid % nig) / gsz; return true;
    }
};

template <class Epi>
__device__ __forceinline__ void gemm_phase(LAS unsigned char* lds, const Gemm g, const StaticOrder& S, const Epi& E) {
    int tid_ = threadIdx.x; asm volatile("" : "+v"(tid_));
    const int tid = tid_, wid = __builtin_amdgcn_readfirstlane(tid >> 6), lane = tid & 63, wr = wid >> 2, wc = wid & 3, fr = lane & 15, fq = lane >> 4;
    const int K = g.K, nt = K / BK;
    unsigned voffA[2], voffB[2];
#pragma unroll
    for (int i = 0; i < 2; ++i) { int R, C; stage_rc(tid * 16 + i * 8192, R, C); const int Rb = (R & ~31) + perm32(R & 31);
        voffA[i] = (unsigned)(R * K + C) * 2u; voffB[i] = (unsigned)(Rb * K + C) * 2u; }
    const size_t kstep = (size_t)(BK * 2);
    const size_t hstep = (size_t)HALF * K * 2;
    const size_t tstep = 2 * hstep;
    const unsigned ldsw = (unsigned)wid * 1024u;
    const int aoff = lds_byte(wr * 64 + fr, fq * 8), boff = lds_byte(wc * 32 + fr, fq * 8);
#define PG8_SA(b, h) (((b) * 2 + (h)) * HTB)
#define PG8_SB(b, h) ((4 + (b) * 2 + (h)) * HTB)
#define PG8_STAGE(bufoff, gbase, voff) do { _Pragma("unroll") for (int _i = 0; _i < 2; ++_i) \
        __builtin_amdgcn_global_load_lds((const __attribute__((address_space(1))) unsigned*)((const char*)(gbase) + (voff)[_i]), (LAS unsigned*)(lds + (bufoff) + ldsw + _i * 8192), 16, 0, 0); } while (0)
#define PG8_LDA(dst, b, h) do { _Pragma("unroll") for (int m = 0; m < 4; ++m) _Pragma("unroll") for (int k = 0; k < 2; ++k) dst[m][k] = *(const LAS bf16x8*)(lds + PG8_SA(b, h) + aoff + m * 2048 + k * 1024); } while (0)
#define PG8_LDB(dst, b, h) do { _Pragma("unroll") for (int n = 0; n < 2; ++n) _Pragma("unroll") for (int k = 0; k < 2; ++k) dst[n][k] = *(const LAS bf16x8*)(lds + PG8_SB(b, h) + boff + n * 2048 + k * 1024); } while (0)
#define PG8_MMA(ai, bj, At, Bt) do { __builtin_amdgcn_s_setprio(1); _Pragma("unroll") for (int m = 0; m < 4; ++m) _Pragma("unroll") for (int n = 0; n < 2; ++n) _Pragma("unroll") for (int k = 0; k < 2; ++k) \
        acc[ai][bj][m][n] = __builtin_amdgcn_mfma_f32_16x16x32_bf16(Bt[n][k], At[m][k], acc[ai][bj][m][n], 0, 0, 0); __builtin_amdgcn_s_setprio(0); } while (0)
#define PG8_WAIT_V(n) asm volatile("s_waitcnt vmcnt(" #n ")" ::: "memory")
#define PG8_WAIT_L(n) asm volatile("s_waitcnt lgkmcnt(" #n ")" ::: "memory")
#define PG8_BAR __builtin_amdgcn_s_barrier()
#define PG8_SCHED __builtin_amdgcn_sched_barrier(0)
    Unit cur, nxt; int ui = 0;
    if (!S.next(0, cur)) return;
    f32x4 acc[2][2][4][2];
#pragma unroll
    for (int a = 0; a < 2; ++a)
#pragma unroll
        for (int b = 0; b < 2; ++b)
#pragma unroll
            for (int m = 0; m < 4; ++m)
#pragma unroll
                for (int n = 0; n < 2; ++n) acc[a][b][m][n] = (f32x4){0.f, 0.f, 0.f, 0.f};
    bf16x8 At[4][2], B0[2][2], B1[2][2];
    const char* cA = (const char*)g.A + (size_t)cur.pm * tstep; const char* cB = (const char*)g.Bt + (size_t)cur.pn * tstep;
    PG8_STAGE(PG8_SB(0, 0), cB, voffB); PG8_STAGE(PG8_SB(0, 1), cB + hstep, voffB); PG8_STAGE(PG8_SA(0, 0), cA, voffA); PG8_STAGE(PG8_SA(0, 1), cA + hstep, voffA);
    if (wr == 1) PG8_BAR;
    PG8_WAIT_V(2); PG8_BAR;
    PG8_STAGE(PG8_SB(1, 0), cB + kstep, voffB); PG8_STAGE(PG8_SA(1, 0), cA + kstep, voffA); PG8_STAGE(PG8_SB(1, 1), cB + hstep + kstep, voffB);
    PG8_WAIT_V(6); PG8_BAR;
    for (;;) {
        const bool has_next = S.next(ui + 1, nxt);
        const char* nA = has_next ? (const char*)g.A + (size_t)nxt.pm * tstep : cA; const char* nB = has_next ? (const char*)g.Bt + (size_t)nxt.pn * tstep : cB;
#pragma nounroll
        for (int t = 0; t < nt; t += 2) {
            const bool last = (t == nt - 2);
            const char* a1 = cA + (size_t)(t + 1) * kstep;
            const char* a2 = last ? nA : cA + (size_t)(t + 2) * kstep; const char* b2 = last ? nB : cB + (size_t)(t + 2) * kstep;
            const char* a3 = a2 + kstep; const char* b3 = b2 + kstep;
            PG8_LDB(B0, 0, 0); PG8_LDB(B1, 0, 1); PG8_SCHED; PG8_LDA(At, 0, 0); PG8_STAGE(PG8_SA(1, 1), a1 + hstep, voffA);
            PG8_WAIT_V(8); PG8_WAIT_L(0); PG8_BAR; PG8_MMA(0, 0, At, B0); PG8_MMA(0, 1, At, B1); PG8_BAR; PG8_SCHED;
            PG8_LDA(At, 0, 1); PG8_STAGE(PG8_SB(0, 0), b2, voffB); PG8_STAGE(PG8_SB(0, 1), b2 + hstep, voffB); PG8_STAGE(PG8_SA(0, 0), a2, voffA);
            PG8_WAIT_V(8); PG8_WAIT_L(0); PG8_BAR; PG8_MMA(1, 0, At, B0); PG8_MMA(1, 1, At, B1); PG8_BAR; PG8_SCHED;
            PG8_LDB(B0, 1, 0); PG8_LDB(B1, 1, 1); PG8_SCHED; PG8_LDA(At, 1, 0); PG8_STAGE(PG8_SA(0, 1), a2 + hstep, voffA);
            PG8_WAIT_V(8); PG8_WAIT_L(0); PG8_BAR; PG8_MMA(0, 0, At, B0); PG8_MMA(0, 1, At, B1); PG8_BAR; PG8_SCHED;
            PG8_LDA(At, 1, 1); PG8_STAGE(PG8_SB(1, 0), b3, voffB); PG8_STAGE(PG8_SB(1, 1), b3 + hstep, voffB); PG8_STAGE(PG8_SA(1, 0), a3, voffA);
            PG8_WAIT_V(8); PG8_WAIT_L(0); PG8_BAR; PG8_MMA(1, 0, At, B0); PG8_MMA(1, 1, At, B1); PG8_BAR; PG8_SCHED;
        }
        if (wr == 0) PG8_BAR;
        E(acc, cur, wr, wc, fr, fq);
        if (!has_next) break;
#pragma unroll
        for (int a = 0; a < 2; ++a)
#pragma unroll
            for (int b = 0; b < 2; ++b)
#pragma unroll
                for (int m = 0; m < 4; ++m)
#pragma unroll
                    for (int n = 0; n < 2; ++n) acc[a][b][m][n] = (f32x4){0.f, 0.f, 0.f, 0.f};
        cur = nxt; cA = nA; cB = nB; ++ui;
        if (wr == 1) PG8_BAR;
    }
    PG8_WAIT_V(0);
    PG8_BAR;
#undef PG8_SA
#undef PG8_SB
#undef PG8_STAGE
#undef PG8_LDA
#undef PG8_LDB
#undef PG8_MMA
#undef PG8_WAIT_V
#undef PG8_WAIT_L
#undef PG8_BAR
#undef PG8_SCHED
}
}
using pg8::Unit;

typedef f32x4 AccT[2][2][4][2];

#define OPAQUE(o) asm volatile("" : "+v"(o))
struct EpiPlain {
    bf16_t* O; int ldc;
    __device__ __forceinline__ void operator()(const AccT& acc, const Unit& u, int wr, int wc, int fr, int fq) const {
        const unsigned lo = (unsigned)((u.pm * 256 + wr * 64 + fr) * ldc + u.pn * 256 + wc * 32 + 8 * fq) * 2u;
#pragma unroll
        for (int ai = 0; ai < 2; ++ai)
#pragma unroll
            for (int m = 0; m < 4; ++m) { unsigned o = lo + (unsigned)((ai * 128 + m * 16) * ldc) * 2u; OPAQUE(o); char* rowp = (char*)O + o;
#pragma unroll
                for (int bj = 0; bj < 2; ++bj) { const f32x4 v0 = acc[ai][bj][m][0], v1 = acc[ai][bj][m][1];
                    u32x4 w; w.x = cvt_pk_bf16(v0[0], v0[1]); w.y = cvt_pk_bf16(v0[2], v0[3]); w.z = cvt_pk_bf16(v1[0], v1[1]); w.w = cvt_pk_bf16(v1[2], v1[3]);
                    *(u32x4*)(rowp + bj * 256) = w; } }
    }
};
struct EpiSwiglu {
    bf16_t* O;
    __device__ __forceinline__ void operator()(const AccT& acc, const Unit& u, int wr, int wc, int fr, int fq) const {
        const unsigned lo = (unsigned)((u.pm * 256 + wr * 64 + fr) * FF + u.pn * 128 + wc * 32 + 8 * fq) * 2u;
#pragma unroll
        for (int ai = 0; ai < 2; ++ai)
#pragma unroll
            for (int m = 0; m < 4; ++m) { unsigned o = lo + (unsigned)((ai * 128 + m * 16) * FF) * 2u; OPAQUE(o); char* rowp = (char*)O + o;
                float r[8];
#pragma unroll
                for (int n = 0; n < 2; ++n)
#pragma unroll
                    for (int j = 0; j < 4; ++j) { const float gt = acc[ai][0][m][n][j], up = acc[ai][1][m][n][j]; r[n * 4 + j] = gt * sigmoidf_(gt) * up; }
                u32x4 w; w.x = cvt_pk_bf16(r[0], r[1]); w.y = cvt_pk_bf16(r[2], r[3]); w.z = cvt_pk_bf16(r[4], r[5]); w.w = cvt_pk_bf16(r[6], r[7]);
                *(u32x4*)rowp = w; }
    }
};
struct EpiProj {
    bf16_t* O; const float* rope; const float* bgate; int posmask;
    __device__ __forceinline__ void operator()(const AccT& acc, const Unit& u, int wr, int wc, int fr, int fq) const {
        const int pn = u.pn;
        const int row0 = u.pm * 256 + wr * 64 + fr, col0 = pn * 256 + wc * 32 + 8 * fq;
        const unsigned lo = (unsigned)(row0 * INW + col0) * 2u;
        const bool ropeTile = pn < 6, gateTile = pn >= 15;
        const float sc = (pn < 3 || pn == 9 || pn == 10) ? QSCALE : 1.0f;
        const bool rot = ropeTile && ((wc & 1) == 0) && (fq < 2);
        if (gateTile) {
#pragma unroll
            for (int bj = 0; bj < 2; ++bj) { const f32x4 b0 = *(const f32x4*)(bgate + col0 - GOFF + bj * 128), b1 = *(const f32x4*)(bgate + col0 - GOFF + bj * 128 + 4);
#pragma unroll
                for (int ai = 0; ai < 2; ++ai)
#pragma unroll
                    for (int m = 0; m < 4; ++m) { unsigned o = lo + (unsigned)((ai * 128 + m * 16) * INW) * 2u + bj * 256; OPAQUE(o);
                        f32x4 v0 = acc[ai][bj][m][0] + b0, v1 = acc[ai][bj][m][1] + b1;
#pragma unroll
                        for (int j = 0; j < 4; ++j) { v0[j] = sigmoidf_(v0[j]); v1[j] = sigmoidf_(v1[j]); }
                        u32x4 w; w.x = cvt_pk_bf16(v0[0], v0[1]); w.y = cvt_pk_bf16(v0[2], v0[3]); w.z = cvt_pk_bf16(v1[0], v1[1]); w.w = cvt_pk_bf16(v1[2], v1[3]);
                        *(u32x4*)((char*)O + o) = w; } }
        } else {
#pragma unroll
            for (int ai = 0; ai < 2; ++ai)
#pragma unroll
                for (int m = 0; m < 4; ++m) { unsigned o = lo + (unsigned)((ai * 128 + m * 16) * INW) * 2u; OPAQUE(o);
                    f32x4 cs = (f32x4){1.f, 1.f, 1.f, 1.f}, sn = (f32x4){0.f, 0.f, 0.f, 0.f};
                    if (rot) { unsigned ro = (unsigned)(((row0 + ai * 128 + m * 16) & posmask) * 16 + 4 * fq) * 4u; OPAQUE(ro); cs = *(const f32x4*)((const char*)rope + ro); sn = *(const f32x4*)((const char*)rope + ro + 32); }
#pragma unroll
                    for (int bj = 0; bj < 2; ++bj) { f32x4 v0 = acc[ai][bj][m][0], v1 = acc[ai][bj][m][1];
                        if (ropeTile) { const f32x4 x1 = v0, x2 = v1; v0 = x1 * cs - x2 * sn; v1 = x2 * cs + x1 * sn; }
                        v0 = v0 * sc; v1 = v1 * sc;
                        u32x4 w; w.x = cvt_pk_bf16(v0[0], v0[1]); w.y = cvt_pk_bf16(v0[2], v0[3]); w.z = cvt_pk_bf16(v1[0], v1[1]); w.w = cvt_pk_bf16(v1[2], v1[3]);
                        *(u32x4*)((char*)O + o + bj * 256) = w; }
                    asm volatile("" ::: "memory"); }
        }
    }
};
template <bool ADD> struct EpiGate {
    bf16_t* Z; const bf16_t* P; int goff;
    __device__ __forceinline__ void operator()(const AccT& acc, const Unit& u, int wr, int wc, int fr, int fq) const {
        const int row0 = u.pm * 256 + wr * 64 + fr, col0 = u.pn * 256 + wc * 32 + 8 * fq;
        const unsigned zl = (unsigned)(row0 * DM + col0) * 2u, gl = (unsigned)(row0 * INW + goff + col0) * 2u;
#pragma unroll
        for (int ai = 0; ai < 2; ++ai)
#pragma unroll
            for (int m = 0; m < 4; ++m) {
                unsigned zo_ = zl + (unsigned)((ai * 128 + m * 16) * DM) * 2u, go_ = gl + (unsigned)((ai * 128 + m * 16) * INW) * 2u; OPAQUE(zo_); OPAQUE(go_);
                char* zp = (char*)Z + zo_; const char* gp = (const char*)P + go_;
#pragma unroll
                for (int bj = 0; bj < 2; ++bj) { const f32x4 v0 = acc[ai][bj][m][0], v1 = acc[ai][bj][m][1];
                    const u32x4 gw = *(const u32x4*)(gp + bj * 256);
                    float r[8];
                    r[0] = bf_lo(gw.x) * v0[0]; r[1] = bf_hi(gw.x) * v0[1]; r[2] = bf_lo(gw.y) * v0[2]; r[3] = bf_hi(gw.y) * v0[3];
                    r[4] = bf_lo(gw.z) * v1[0]; r[5] = bf_hi(gw.z) * v1[1]; r[6] = bf_lo(gw.w) * v1[2]; r[7] = bf_hi(gw.w) * v1[3];
                    if (ADD) { const u32x4 zo = *(const u32x4*)(zp + bj * 256);
                        r[0] += bf_lo(zo.x); r[1] += bf_hi(zo.x); r[2] += bf_lo(zo.y); r[3] += bf_hi(zo.y); r[4] += bf_lo(zo.z); r[5] += bf_hi(zo.z); r[6] += bf_lo(zo.w); r[7] += bf_hi(zo.w); }
                    u32x4 w; w.x = cvt_pk_bf16(r[0], r[1]); w.y = cvt_pk_bf16(r[2], r[3]); w.z = cvt_pk_bf16(r[4], r[5]); w.w = cvt_pk_bf16(r[6], r[7]);
                    *(u32x4*)(zp + bj * 256) = w; }
                asm volatile("" ::: "memory"); }
    }
};

struct Args {
    const float* in[20];
    float* out;
    unsigned char* ws;
};

__device__ __forceinline__ void transpose_item(const float* W, int ldw, int sc, bf16_t* WT, int K, int n0, int k0, LAS float* scr, int lane) {
#pragma unroll 8
    for (int i = 0; i < 32; ++i) { const int kk = 2 * i + (lane >> 5); scr[kk * 33 + (lane & 31)] = W[(size_t)(k0 + kk) * ldw + sc]; }
    asm volatile("s_waitcnt lgkmcnt(0)" ::: "memory");
    const int c = lane & 7;
#pragma unroll
    for (int j = 0; j < 4; ++j) { const int n = (lane >> 3) + 8 * j; const LAS float* s = scr + (8 * c) * 33 + n;
        u32x4 o; o.x = cvt_pk_bf16(s[0 * 33], s[1 * 33]); o.y = cvt_pk_bf16(s[2 * 33], s[3 * 33]); o.z = cvt_pk_bf16(s[4 * 33], s[5 * 33]); o.w = cvt_pk_bf16(s[6 * 33], s[7 * 33]);
        *(u32x4*)(WT + (size_t)(n0 + n) * K + k0 + 8 * c) = o; }
    asm volatile("s_waitcnt lgkmcnt(0)" ::: "memory");
}
template <int KIND>
__device__ __forceinline__ void transpose_items(const float* W0, const float* W1, int ldw, bf16_t* WT, int K, int N, LAS float* scr, int lane, int gw, int NGW) {
    const int nblk = N / 32, nitems = (K / 64) * nblk;
    for (int it = gw; it < nitems; it += NGW) {
        const int kb = it / nblk, nb = it % nblk, n0 = nb * 32, n = n0 + (lane & 31);
        const float* W = W0; int sc = n;
        if (KIND == 1) { const int tile = n >> 8, bj = (n >> 7) & 1, j = n & 127; W = bj ? W1 : W0; sc = tile * 128 + j; }
        if (KIND == 2) { if (n < 1536 && (n & 63) < 16) { const int p = n & 15; const int d = (p < 8) ? ((p & 3) + ((p >> 2) << 3)) : (4 + (p & 3) + (((p - 8) >> 2) << 3)); sc = (n & ~15) + d; } }
        transpose_item(W, ldw, sc, WT, K, n0, kb * 64, scr, lane);
    }
}

template <bool HAS_D, bool HAS_H>
__device__ __forceinline__ void row_pass(const float* xa, const float* xb, const bf16_t* D, const float* gpost, float dscale, float* xout, const float* gpre, bf16_t* hout, int lane, int gw, int NGW) {
    f32x4 gp[4], gq[4];
#pragma unroll
    for (int j = 0; j < 4; ++j) { if (HAS_D) gp[j] = *(const f32x4*)(gpost + 4 * lane + 256 * j); if (HAS_H) gq[j] = *(const f32x4*)(gpre + 4 * lane + 256 * j); }
    for (int row = gw; row < TALL; row += NGW) {
        const float* xr = (row < TP) ? xa + (size_t)row * DM : xb + (size_t)(row - TP) * DM;
        f32x4 v[4];
#pragma unroll
        for (int j = 0; j < 4; ++j) v[j] = *(const f32x4*)(xr + 4 * lane + 256 * j);
        if (HAS_D) {
            f32x4 d[4]; float ss = 0.f;
#pragma unroll
            for (int j = 0; j < 4; ++j) { const u32x2 w = *(const u32x2*)(D + (size_t)row * DM + 4 * lane + 256 * j);
                d[j] = (f32x4){bf_lo(w.x), bf_hi(w.x), bf_lo(w.y), bf_hi(w.y)}; ss += (d[j][0] * d[j][0] + d[j][1] * d[j][1]) + (d[j][2] * d[j][2] + d[j][3] * d[j][3]); }
            const float r = dscale * __builtin_amdgcn_rsqf(wave_sum(ss) * (1.0f / DM) + RMS_EPS);
#pragma unroll
            for (int j = 0; j < 4; ++j) { v[j] = v[j] + d[j] * gp[j] * r; *(f32x4*)(xout + (size_t)row * DM + 4 * lane + 256 * j) = v[j]; }
        }
        if (HAS_H) {
            float ss = 0.f;
#pragma unroll
            for (int j = 0; j < 4; ++j) ss += (v[j][0] * v[j][0] + v[j][1] * v[j][1]) + (v[j][2] * v[j][2] + v[j][3] * v[j][3]);
            const float r = __builtin_amdgcn_rsqf(wave_sum(ss) * (1.0f / DM) + RMS_EPS);
#pragma unroll
            for (int j = 0; j < 4; ++j) { const f32x4 o = v[j] * gq[j] * r; u32x2 w; w.x = cvt_pk_bf16(o[0], o[1]); w.y = cvt_pk_bf16(o[2], o[3]);
                *(u32x2*)(hout + (size_t)row * DM + 4 * lane + 256 * j) = w; }
        }
    }
}

constexpr int KS = 144;
constexpr int WAVE_LDS = 2 * 32 * KS;
constexpr int RPB_OFF = 81920;
__device__ __forceinline__ int crow(int r, int hi) { return (r & 3) + 8 * (r >> 2) + 4 * hi; }
__device__ __forceinline__ s16x4 vtr(LAS const unsigned char* p) { return __builtin_bit_cast(s16x4, __builtin_amdgcn_ds_read_tr16_b64_v4i16((LAS s16x4*)p)); }

struct KVRegs { u32x4 k[4], v[4]; };

#define ATT_LOAD(R, tokexpr) do { _Pragma("unroll") for (int _i = 0; _i < 4; ++_i) { const int _rowi = (lane >> 3) + 8 * _i; const size_t _tok = (size_t)(tokexpr); \
        const bf16_t* _p = proj + _tok * INW + 8 * (lane & 7); R.k[_i] = *(const u32x4*)(_p + kcol); R.v[_i] = *(const u32x4*)(_p + vcol); } } while (0)
#define ATT_STORE(R) do { _Pragma("unroll") for (int _i = 0; _i < 4; ++_i) { const int _rowi = (lane >> 3) + 8 * _i; \
        *(LAS u32x4*)(wl + _rowi * KS + 16 * (lane & 7)) = R.k[_i]; *(LAS u32x4*)(wl + 32 * KS + _rowi * KS + 16 * (lane & 7)) = R.v[_i]; } } while (0)
#define ATT_QK(s) do { s = (f32x16){0.f,0.f,0.f,0.f,0.f,0.f,0.f,0.f,0.f,0.f,0.f,0.f,0.f,0.f,0.f,0.f}; _Pragma("unroll") for (int _d = 0; _d < 4; ++_d) { \
        const bf16x8 _kf = *(const LAS bf16x8*)(wl + q32 * KS + 32 * _d + 16 * hi); s = __builtin_amdgcn_mfma_f32_32x32x16_bf16(_kf, qr[_d], s, 0, 0, 0); } } while (0)
#define ATT_SOFTMAX_PV(s) do { \
        float _tm = s[0]; _Pragma("unroll") for (int _r = 1; _r < 16; ++_r) _tm = fmaxf(_tm, s[_r]); \
        _tm = fmaxf(_tm, __shfl_xor(_tm, 32)); \
        const float _mn = fmaxf(m_run, _tm), _al = fexp2(m_run - _mn); m_run = _mn; \
        float _sum = 0.f; _Pragma("unroll") for (int _r = 0; _r < 16; ++_r) { s[_r] = fexp2(s[_r] - _mn); _sum += s[_r]; } \
        l_run = l_run * _al + _sum; \
        _Pragma("unroll") for (int _r = 0; _r < 16; ++_r) { oT0[_r] *= _al; oT1[_r] *= _al; } \
        u32x4 _p0, _p1; _p0.x = cvt_pk_bf16(s[0], s[1]); _p0.y = cvt_pk_bf16(s[2], s[3]); _p0.z = cvt_pk_bf16(s[4], s[5]); _p0.w = cvt_pk_bf16(s[6], s[7]); \
        _p1.x = cvt_pk_bf16(s[8], s[9]); _p1.y = cvt_pk_bf16(s[10], s[11]); _p1.z = cvt_pk_bf16(s[12], s[13]); _p1.w = cvt_pk_bf16(s[14], s[15]); \
        const bf16x8 _pb0 = __builtin_bit_cast(bf16x8, _p0), _pb1 = __builtin_bit_cast(bf16x8, _p1); \
        { const s16x4 a = vtr(vtb), b = vtr(vtb + 8 * KS); const bf16x8 vf = (bf16x8){a[0], a[1], a[2], a[3], b[0], b[1], b[2], b[3]}; oT0 = __builtin_amdgcn_mfma_f32_32x32x16_bf16(vf, _pb0, oT0, 0, 0, 0); } \
        { const s16x4 a = vtr(vtb + 16 * KS), b = vtr(vtb + 24 * KS); const bf16x8 vf = (bf16x8){a[0], a[1], a[2], a[3], b[0], b[1], b[2], b[3]}; oT0 = __builtin_amdgcn_mfma_f32_32x32x16_bf16(vf, _pb1, oT0, 0, 0, 0); } \
        { const s16x4 a = vtr(vtb + 64), b = vtr(vtb + 64 + 8 * KS); const bf16x8 vf = (bf16x8){a[0], a[1], a[2], a[3], b[0], b[1], b[2], b[3]}; oT1 = __builtin_amdgcn_mfma_f32_32x32x16_bf16(vf, _pb0, oT1, 0, 0, 0); } \
        { const s16x4 a = vtr(vtb + 64 + 16 * KS), b = vtr(vtb + 64 + 24 * KS); const bf16x8 vf = (bf16x8){a[0], a[1], a[2], a[3], b[0], b[1], b[2], b[3]}; oT1 = __builtin_amdgcn_mfma_f32_32x32x16_bf16(vf, _pb1, oT1, 0, 0, 0); } \
    } while (0)
#define ATT_WRITE_O(orow) do { \
        _Pragma("unroll") for (int _g = 0; _g < 4; ++_g) { \
            u32x2 w0, w1; w0.x = cvt_pk_bf16(oT0[4 * _g] * inv, oT0[4 * _g + 1] * inv); w0.y = cvt_pk_bf16(oT0[4 * _g + 2] * inv, oT0[4 * _g + 3] * inv); \
            w1.x = cvt_pk_bf16(oT1[4 * _g] * inv, oT1[4 * _g + 1] * inv); w1.y = cvt_pk_bf16(oT1[4 * _g + 2] * inv, oT1[4 * _g + 3] * inv); \
            *(u32x2*)((orow) + 8 * _g + 4 * hi) = w0; *(u32x2*)((orow) + 32 + 8 * _g + 4 * hi) = w1; } } while (0)

__device__ __forceinline__ void attnA_unit(int u, const bf16_t* proj, bf16_t* og, float* lse, int S, LAS unsigned char* wl, int lane) {
    const int q32 = lane & 31, hi = lane >> 5;
    const int g = u / 2048, rem = u % 2048, h = rem / 512, idx = rem % 512;
    const int per_seq = S / 32, seq = idx / per_seq, ii = idx % per_seq;
    const int dsh = 2 * g, dl = 1 << dsh;
    const int r = ii & (dl - 1), c = ii >> dsh, L = S >> dsh;
    const int hd = 4 * g + h, qcol = hd * 64, kcol = 768 + hd * 64, vcol = 1536 + hd * 64;
    const size_t seqbase = (size_t)seq * S;
    const int qm = 32 * c + q32;
    const size_t qtok = seqbase + (size_t)qm * dl + r;
    bf16x8 qr[4];
#pragma unroll
    for (int d = 0; d < 4; ++d) qr[d] = *(const bf16x8*)(proj + qtok * INW + qcol + 16 * d + 8 * hi);
    const int m0 = 32 * c - 64;
    LAS const unsigned char* vtb = wl + 32 * KS + (4 * hi + ((lane & 15) >> 2)) * KS + (16 * ((lane >> 4) & 1) + 4 * (lane & 3)) * 2;
    float m_run = -1e29f, l_run = 0.f;
    f32x16 oT0 = (f32x16){0.f,0.f,0.f,0.f,0.f,0.f,0.f,0.f,0.f,0.f,0.f,0.f,0.f,0.f,0.f,0.f}, oT1 = oT0;
    KVRegs R;
#define TOKA(t) (seqbase + (size_t)min(max(m0 + 32 * (t) + _rowi, 0), L - 1) * dl + r)
    ATT_LOAD(R, TOKA(0));
    for (int t = 0; t < 5; ++t) {
        ATT_STORE(R);
        if (t < 4) { ATT_LOAD(R, TOKA(t + 1)); }
        f32x16 s; ATT_QK(s);
#pragma unroll
        for (int rr = 0; rr < 16; ++rr) { const int km = m0 + 32 * t + crow(rr, hi); const int dk = km - qm;
            const bool ok = (km >= 0) && (km < L) && (dk <= 64) && (dk >= -64); s[rr] = ok ? s[rr] : NEGBIG; }
        ATT_SOFTMAX_PV(s);
    }
#undef TOKA
    const float lt = l_run + __shfl_xor(l_run, 32);
    const float inv = frcp(lt);
    bf16_t* orow = og + qtok * 768 + hd * 64;
    ATT_WRITE_O(orow);
    if (hi == 0) lse[qtok * 12 + hd] = m_run + __builtin_amdgcn_logf(lt);
}

__device__ __forceinline__ void attnB_unit(int u, const bf16_t* proj, bf16_t* ob, int S, LAS unsigned char* wl, LAS const float* rpbL, int lane) {
    const int q32 = lane & 31, hi = lane >> 5;
    const int h = u / 512, idx = u % 512;
    const int per_seq = S / 32, seq = idx / per_seq, ii = idx % per_seq;
    const int rp = ii >> 2, cc = ii & 3, rows = S / 64;
    const int ri0 = 2 * rp, qrow = ri0 + (q32 >> 4), qcolg = 16 * cc + (q32 & 15);
    const int qcol = 2304 + h * 64, kcol = 2816 + h * 64, vcol = 3328 + h * 64;
    const size_t seqbase = (size_t)seq * S;
    const size_t qtok = seqbase + (size_t)qrow * 64 + qcolg;
    bf16x8 qr[4];
#pragma unroll
    for (int d = 0; d < 4; ++d) qr[d] = *(const bf16x8*)(proj + qtok * INW + qcol + 16 * d + 8 * hi);
    const int w0 = (cc == 0) ? 0 : (cc == 1) ? 8 : (cc == 2) ? 24 : 32;
    const int rs0 = min(max(ri0 - 4, 0), rows - 8), rs1 = min(max(ri0 - 3, 0), rows - 8);
    const int ntile = rs1 + 8 - rs0;
    const int rsq = min(max(qrow - 4, 0), rows - 8), csq = min(max(qcolg - 8, 0), 48);
    LAS const unsigned char* vtb = wl + 32 * KS + (4 * hi + ((lane & 15) >> 2)) * KS + (16 * ((lane >> 4) & 1) + 4 * (lane & 3)) * 2;
    LAS const float* rb = rpbL + h * 465;
    float m_run = -1e29f, l_run = 0.f;
    f32x16 oT0 = (f32x16){0.f,0.f,0.f,0.f,0.f,0.f,0.f,0.f,0.f,0.f,0.f,0.f,0.f,0.f,0.f,0.f}, oT1 = oT0;
    KVRegs R;
#define TOKB(t) (seqbase + (size_t)(rs0 + (t)) * 64 + w0 + _rowi)
    ATT_LOAD(R, TOKB(0));
    for (int t = 0; t < ntile; ++t) {
        ATT_STORE(R);
        if (t + 1 < ntile) { ATT_LOAD(R, TOKB(t + 1)); }
        f32x16 s; ATT_QK(s);
        const int kr = rs0 + t;
        const bool rowok = (kr >= rsq) && (kr < rsq + 8);
        const int bi0 = (kr - qrow + 7) * 31 + (w0 - qcolg + 15);
#pragma unroll
        for (int rr = 0; rr < 16; ++rr) { const int kv = crow(rr, hi); const int ck = w0 + kv;
            const bool ok = rowok && (ck >= csq) && (ck < csq + 16);
            const int bi = min(max(bi0 + kv, 0), 464);
            s[rr] = ok ? s[rr] + rb[bi] : NEGBIG; }
        ATT_SOFTMAX_PV(s);
    }
#undef TOKB
    const float lt = l_run + __shfl_xor(l_run, 32);
    const float inv = frcp(lt);
    bf16_t* orow = ob + qtok * 512 + h * 64;
    ATT_WRITE_O(orow);
}


#define XB_TMO      128
#define XB_XCNT(j)  (256  + 64 * (j))
#define XB_XSUB(j)  (1280 + 64 * (j))
#define XB_XGEN(j)  (2304 + 64 * (j))
#define XB_TOP      3328
#define XB_TOPGEN   3392
#define XCD_BAR_WORDS 3456
#define XB_SPIN_CAP (1u << 18)
__device__ __forceinline__ unsigned xb_ld(unsigned* p)              { return __hip_atomic_load(p, __ATOMIC_RELAXED, __HIP_MEMORY_SCOPE_AGENT); }
__device__ __forceinline__ unsigned xb_add(unsigned* p, unsigned v) { return __hip_atomic_fetch_add(p, v, __ATOMIC_RELAXED, __HIP_MEMORY_SCOPE_AGENT); }
__device__ __forceinline__ unsigned xb_xcc_id() { return (unsigned)__builtin_amdgcn_s_getreg((3 << 11) | 20) & 0xFu; }
#define XB_SPIN(cond, bar) do { unsigned _sp = 0; while (cond) { __builtin_amdgcn_s_sleep(1); \
    if ((++_sp & 255u) == 0u) { if (xb_ld(&(bar)[XB_TMO])) break; if (_sp > XB_SPIN_CAP) { atomicAdd(&(bar)[XB_TMO], 1u); break; } } } } while (0)
struct XcdBarrier { unsigned* bar; unsigned x; volatile LAS unsigned* st; };
__device__ __forceinline__ XcdBarrier xcd_barrier_post(unsigned* bar, volatile LAS unsigned* st) {
    XcdBarrier b; b.bar = bar; b.x = xb_xcc_id(); b.st = st;
    if (threadIdx.x == 0) (void)xb_add(&bar[XB_XCNT(b.x)], 1u);
    return b;
}
__device__ __forceinline__ void xcd_barrier_complete(unsigned* bar, unsigned x, unsigned& nloc, unsigned& nx) {
    const unsigned G = gridDim.x * gridDim.y * gridDim.z;
    unsigned sum, cnt, mine, sp = 0u;
    for (;;) {
        sum = 0u; cnt = 0u; mine = 0u;
#pragma unroll
        for (unsigned j = 0; j < 16; ++j) { const unsigned c = xb_ld(&bar[XB_XCNT(j)]); sum += c; cnt += (c > 0u) ? 1u : 0u; mine = (j == x) ? c : mine; }
        if (sum == G) break;
        __builtin_amdgcn_s_sleep(1);
        if ((++sp & 255u) == 0u) { if (xb_ld(&bar[XB_TMO])) break; if (sp > XB_SPIN_CAP) { atomicAdd(&bar[XB_TMO], 1u); break; } }
    }
    nloc = mine > 0u ? mine : 1u; nx = cnt > 0u ? cnt : 1u;
}
__device__ __forceinline__ void xcd_barrier(const XcdBarrier& b) {
    asm volatile("s_waitcnt vmcnt(0)" ::: "memory");
    __syncthreads();
    if (threadIdx.x == 0) {
        unsigned* bar = b.bar;
        __builtin_amdgcn_s_waitcnt(0);
        unsigned nloc = b.st[0], nx = b.st[1];
        if (nloc == 0u) { xcd_barrier_complete(bar, b.x, nloc, nx); b.st[0] = nloc; b.st[1] = nx; }
        const unsigned old = xb_add(&bar[XB_XSUB(b.x)], 1u);
        const unsigned gen = old / nloc;
        if (old + 1u == (gen + 1u) * nloc) {
            __builtin_amdgcn_fence(__ATOMIC_RELEASE, "agent");
            asm volatile("s_waitcnt vmcnt(0)" ::: "memory");
            const unsigned og = xb_add(&bar[XB_TOP], 1u);
            const unsigned tg = og / nx;
            if (og + 1u == (tg + 1u) * nx) xb_add(&bar[XB_TOPGEN], 1u);
            else XB_SPIN(xb_ld(&bar[XB_TOPGEN]) == tg, bar);
            __builtin_amdgcn_fence(__ATOMIC_ACQUIRE, "agent");
            xb_add(&bar[XB_XGEN(b.x)], 1u);
            asm volatile("s_waitcnt vmcnt(0)" ::: "memory");
        } else {
            XB_SPIN(xb_ld(&bar[XB_XGEN(b.x)]) == gen, bar);
            __builtin_amdgcn_fence(__ATOMIC_ACQUIRE, "agent");
            asm volatile("s_waitcnt vmcnt(0)" ::: "memory");
        }
    }
    __syncthreads();
}

#define CGSYNC() do { asm volatile("s_waitcnt vmcnt(0) lgkmcnt(0)" ::: "memory"); grid.sync(); __builtin_amdgcn_fence(__ATOMIC_ACQUIRE, "agent"); asm volatile("s_waitcnt vmcnt(0)" ::: "memory"); } while (0)
#define GSYNC() xcd_barrier(xbar)

template <int CH>
__device__ __forceinline__ void mixer_chunk(const XcdBarrier& xbar, LAS unsigned char* lds, int G, int gw, int NGW, const bf16_t* H, const bf16_t* Win, const bf16_t* Wa, const bf16_t* Wb, const bf16_t* Wout,
        bf16_t* proj, bf16_t* og, float* lse, bf16_t* oa, bf16_t* ob, bf16_t* Z, bf16_t* Dbuf, const float* rope, const float* bgate, const float* rpb) {
    int tid_ = threadIdx.x; asm volatile("" : "+v"(tid_));
    const int tid = tid_, lane = tid & 63, wid = __builtin_amdgcn_readfirstlane(tid >> 6);
    pg8::StaticOrder SO;

        constexpr int ch = CH; constexpr int S = (CH == 0) ? 8192 : 16384;
        const bf16_t* Hc = H + (size_t)ch * TC * DM;
        { pg8::Gemm g{Hc, Win, TC, INW, DM}; SO.init(TC, INW, G, blockIdx.x); EpiProj E{proj, rope, bgate, S - 1}; pg8::gemm_phase(lds, g, SO, E); }
        GSYNC();
        {
            LAS unsigned char* wl = lds + wid * WAVE_LDS;
            for (int u = gw; u < 3 * 4 * (TC / 32); u += NGW) { if (!SKIP_A) attnA_unit(u, proj, og, lse, S, wl, lane); }
        }
        GSYNC();
        {
            LAS float* rpbL = (LAS float*)(lds + RPB_OFF);
            for (int i = tid; i < 8 * 465; i += NTHR) rpbL[i] = rpb[i] * LOG2E;
            __syncthreads();
            LAS unsigned char* wl = lds + wid * WAVE_LDS;
            for (int u = gw; u < 8 * (TC / 32); u += NGW) { if (!SKIP_B) attnB_unit(u, proj, ob, S, wl, rpbL, lane); }
            for (int i = blockIdx.x * NTHR + tid; i < TC * 32; i += G * NTHR) {
                const int tl = i >> 5, h = (i >> 3) & 3, c8 = i & 7;
                const float l0 = lse[tl * 12 + h], l1 = lse[tl * 12 + 4 + h], l2 = lse[tl * 12 + 8 + h];
                const float mx = fmaxf(l0, fmaxf(l1, l2));
                float e0 = fexp2(l0 - mx), e1 = fexp2(l1 - mx), e2 = fexp2(l2 - mx);
                const float is = frcp(e0 + e1 + e2); e0 *= is; e1 *= is; e2 *= is;
                const bf16_t* p = og + (size_t)tl * 768 + h * 64 + c8 * 8;
                const u32x4 v0 = *(const u32x4*)p, v1 = *(const u32x4*)(p + 256), v2 = *(const u32x4*)(p + 512);
                u32x4 w;
                w.x = cvt_pk_bf16(e0 * bf_lo(v0.x) + e1 * bf_lo(v1.x) + e2 * bf_lo(v2.x), e0 * bf_hi(v0.x) + e1 * bf_hi(v1.x) + e2 * bf_hi(v2.x));
                w.y = cvt_pk_bf16(e0 * bf_lo(v0.y) + e1 * bf_lo(v1.y) + e2 * bf_lo(v2.y), e0 * bf_hi(v0.y) + e1 * bf_hi(v1.y) + e2 * bf_hi(v2.y));
                w.z = cvt_pk_bf16(e0 * bf_lo(v0.z) + e1 * bf_lo(v1.z) + e2 * bf_lo(v2.z), e0 * bf_hi(v0.z) + e1 * bf_hi(v1.z) + e2 * bf_hi(v2.z));
                w.w = cvt_pk_bf16(e0 * bf_lo(v0.w) + e1 * bf_lo(v1.w) + e2 * bf_lo(v2.w), e0 * bf_hi(v0.w) + e1 * bf_hi(v1.w) + e2 * bf_hi(v2.w));
                *(u32x4*)(oa + (size_t)tl * 256 + h * 64 + c8 * 8) = w;
            }
        }
        GSYNC();
        { pg8::Gemm g{oa, Wa, TC, DM, 256}; SO.init(TC, DM, G, blockIdx.x); EpiGate<false> E{Z, proj, GOFF}; pg8::gemm_phase(lds, g, SO, E); }
        { pg8::Gemm g{ob, Wb, TC, DM, 512}; SO.init(TC, DM, G, blockIdx.x); EpiGate<true> E{Z, proj, GOFF + DM}; pg8::gemm_phase(lds, g, SO, E); }
        GSYNC();
        { pg8::Gemm g{Z, Wout, TC, DM, DM}; SO.init(TC, DM, G, blockIdx.x); EpiPlain E{Dbuf + (size_t)ch * TC * DM, DM}; pg8::gemm_phase(lds, g, SO, E); }

}

__global__ void __launch_bounds__(NTHR, 2) enc_fwd(Args a) {
    extern __shared__ __attribute__((aligned(16))) unsigned char lds_raw[];
    LAS unsigned char* lds = (LAS unsigned char*)lds_raw;
    cg::grid_group grid = cg::this_grid();
    const int tid = threadIdx.x, lane = tid & 63, wid = __builtin_amdgcn_readfirstlane(tid >> 6);
    const int G = gridDim.x, gw = blockIdx.x * NWAVES + wid, NGW = G * NWAVES;
    unsigned char* ws = a.ws;
    const float* x_p = a.in[0]; const float* x_s = a.in[1];
    bf16_t* Wgu1 = (bf16_t*)(ws + WS_WGU1); bf16_t* Wd1 = (bf16_t*)(ws + WS_WD1); bf16_t* Win = (bf16_t*)(ws + WS_WIN);
    bf16_t* Wa = (bf16_t*)(ws + WS_WA); bf16_t* Wb = (bf16_t*)(ws + WS_WB); bf16_t* Wout = (bf16_t*)(ws + WS_WOUT);
    bf16_t* Wgu2 = (bf16_t*)(ws + WS_WGU2); bf16_t* Wd2 = (bf16_t*)(ws + WS_WD2);
    float* rope = (float*)(ws + WS_ROPE); float* lse = (float*)(ws + WS_LSE);
    bf16_t* H = (bf16_t*)(ws + WS_H); bf16_t* A1 = (bf16_t*)(ws + WS_A1); bf16_t* Dbuf = (bf16_t*)(ws + WS_D);
    bf16_t* proj = (bf16_t*)(ws + WS_PROJ); bf16_t* og = (bf16_t*)(ws + WS_OG); bf16_t* oa = (bf16_t*)(ws + WS_OA); bf16_t* ob = (bf16_t*)(ws + WS_OB); bf16_t* Z = (bf16_t*)(ws + WS_Z);
    float* out = a.out;
    volatile LAS unsigned* xst = (volatile LAS unsigned*)(lds + 131072 + 8192);
    if (tid < 2) xst[tid] = 0u;
    __syncthreads();
    const XcdBarrier xbar = xcd_barrier_post((unsigned*)(ws + WS_BAR), xst);

    {
        LAS float* scr = (LAS float*)(lds + wid * 16384);
        transpose_items<1>(a.in[4], a.in[5], FF, Wgu1, DM, 2 * FF, scr, lane, gw, NGW);
        transpose_items<0>(a.in[6], nullptr, DM, Wd1, FF, DM, scr, lane, gw, NGW);
        transpose_items<2>(a.in[9], nullptr, INW, Win, DM, INW, scr, lane, gw, NGW);
        transpose_items<0>(a.in[12], nullptr, DM, Wa, 256, DM, scr, lane, gw, NGW);
        transpose_items<0>(a.in[13], nullptr, DM, Wb, 512, DM, scr, lane, gw, NGW);
        transpose_items<0>(a.in[14], nullptr, DM, Wout, DM, DM, scr, lane, gw, NGW);
        transpose_items<1>(a.in[17], a.in[18], FF, Wgu2, DM, 2 * FF, scr, lane, gw, NGW);
        transpose_items<0>(a.in[19], nullptr, DM, Wd2, FF, DM, scr, lane, gw, NGW);
        for (int i = blockIdx.x * NTHR + tid; i < 16384 * 8; i += G * NTHR) {
            const int pos = i >> 3, f = i & 7;
            const double invf = (f == 0) ? 1.0 : (f == 1) ? 0.19392274474868576 : (f == 2) ? 0.03760603093086393 : (f == 3) ? 0.007292664737217109 : (f == 4) ? 0.001414213562373095
                              : (f == 5) ? 0.0002742481756762073 : (f == 6) ? 5.318295896944988e-05 : 1.031338537721246e-05;
            const float angf = (float)pos * (float)invf;
            double tt = (double)angf * 0.15915494309189535; tt -= floor(tt);
            const float fr = (float)tt;
            rope[pos * 16 + f] = __builtin_amdgcn_cosf(fr); rope[pos * 16 + 8 + f] = __builtin_amdgcn_sinf(fr);
        }
        row_pass<false, true>(x_p, x_s, nullptr, nullptr, 0.f, nullptr, a.in[2], H, lane, gw, NGW);
    }
    CGSYNC();
    pg8::StaticOrder SO;
    { pg8::Gemm g{H, Wgu1, TALL, 2 * FF, DM}; SO.init(TALL, 2 * FF, G, blockIdx.x); EpiSwiglu E{A1}; pg8::gemm_phase(lds, g, SO, E); }
    GSYNC();
    { pg8::Gemm g{A1, Wd1, TALL, DM, FF}; SO.init(TALL, DM, G, blockIdx.x); EpiPlain E{Dbuf, DM}; pg8::gemm_phase(lds, g, SO, E); }
    GSYNC();
    row_pass<true, true>(x_p, x_s, Dbuf, a.in[3], 0.5f, out, a.in[7], H, lane, gw, NGW);
    GSYNC();
    if (STOP_AFTER <= 1) return;
    if (STOP_AFTER <= 1) return;
    mixer_chunk<0>(xbar, lds, G, gw, NGW, H, Win, Wa, Wb, Wout, proj, og, lse, oa, ob, Z, Dbuf, rope, a.in[10], a.in[11]);
    mixer_chunk<1>(xbar, lds, G, gw, NGW, H, Win, Wa, Wb, Wout, proj, og, lse, oa, ob, Z, Dbuf, rope, a.in[10], a.in[11]);
    mixer_chunk<2>(xbar, lds, G, gw, NGW, H, Win, Wa, Wb, Wout, proj, og, lse, oa, ob, Z, Dbuf, rope, a.in[10], a.in[11]);
    GSYNC();
    row_pass<true, true>(out, out + (size_t)TP * DM, Dbuf, a.in[8], 1.0f, out, a.in[15], H, lane, gw, NGW);
    GSYNC();
    if (STOP_AFTER <= 2) return;
    if (STOP_AFTER <= 2) return;
    { pg8::Gemm g{H, Wgu2, TALL, 2 * FF, DM}; SO.init(TALL, 2 * FF, G, blockIdx.x); EpiSwiglu E{A1}; pg8::gemm_phase(lds, g, SO, E); }
    GSYNC();
    { pg8::Gemm g{A1, Wd2, TALL, DM, FF}; SO.init(TALL, DM, G, blockIdx.x); EpiPlain E{Dbuf, DM}; pg8::gemm_phase(lds, g, SO, E); }
    GSYNC();
    row_pass<true, false>(out, out + (size_t)TP * DM, Dbuf, a.in[16], 0.5f, out, nullptr, nullptr, lane, gw, NGW);
}

extern "C" void kernel_launch(void* const* d_in, const int* in_sizes, int n_in, void* d_out, int out_size, void* d_ws, size_t ws_size, hipStream_t stream) {
    static int grid = 0;
    if (grid == 0) {
        if (n_in != 20 || out_size != TALL * DM || ws_size < WS_END) { fprintf(stderr, "kernel_launch: unexpected shapes (n_in %d out %d ws %zu)\n", n_in, out_size, ws_size); grid = -1; return; }
        int dev = 0, cus = 0, per_cu = 0;
        hipGetDevice(&dev);
        hipDeviceGetAttribute(&cus, hipDeviceAttributeMultiprocessorCount, dev);
        hipFuncSetAttribute((const void*)enc_fwd, hipFuncAttributeMaxDynamicSharedMemorySize, LDS_BYTES);
        hipOccupancyMaxActiveBlocksPerMultiprocessor(&per_cu, (const void*)enc_fwd, NTHR, LDS_BYTES);
        if (per_cu < 1) per_cu = 1;
        grid = cus * per_cu;
        (void)hipGetLastError();
    }
    if (grid < 0) return;
    if (hipMemsetAsync((char*)d_ws + WS_BAR, 0, 16384, stream) != hipSuccess) { fprintf(stderr, "memset of barrier words failed\n"); return; }
    Args a{};
    for (int i = 0; i < 20; ++i) a.in[i] = (const float*)d_in[i];
    a.out = (float*)d_out; a.ws = (unsigned char*)d_ws;
    void* args[] = {&a};
    hipError_t e = hipLaunchCooperativeKernel((const void*)enc_fwd, dim3(grid), dim3(NTHR), args, LDS_BYTES, stream);
    if (e != hipSuccess) fprintf(stderr, "cooperative launch failed: %s (grid %d)\n", hipGetErrorString(e), grid);
}
```

```cpp
#include <hip/hip_runtime.h>
#include <hip/hip_cooperative_groups.h>
#include <cstdio>
#include <cstdint>
namespace cg = cooperative_groups;

#define LAS __attribute__((address_space(3)))
typedef unsigned short bf16_t;
typedef short bf16x8 __attribute__((ext_vector_type(8)));
typedef short s16x4 __attribute__((ext_vector_type(4)));
typedef float f32x4 __attribute__((ext_vector_type(4)));
typedef float f32x16 __attribute__((ext_vector_type(16)));
typedef unsigned u32x4 __attribute__((ext_vector_type(4)));
typedef unsigned u32x2 __attribute__((ext_vector_type(2)));

constexpr int DM = 1024, FF = 2816, TALL = 49152, TP = 16384, TC = 16384, NCH = 3;
constexpr int INW = 5888, GOFF = 3840;
constexpr int NWAVES = 8, NTHR = 512;
constexpr float RMS_EPS = 1e-6f;
constexpr float LOG2E = 1.4426950408889634f;
constexpr float QSCALE = 0.125f * LOG2E;
constexpr float NEGBIG = -1e30f;

constexpr size_t MiB = 1u << 20;
constexpr size_t WS_WGU1 = 0, WS_WD1 = 11 * MiB, WS_WIN = 16 * MiB + MiB / 2, WS_WA = 28 * MiB, WS_WB = 28 * MiB + MiB / 2, WS_WOUT = 29 * MiB + MiB / 2,
                 WS_WGU2 = 31 * MiB + MiB / 2, WS_WD2 = 42 * MiB + MiB / 2, WS_ROPE = 48 * MiB, WS_LSE = 49 * MiB;
constexpr size_t WS_H = 50 * MiB;
constexpr size_t WS_A1 = 146 * MiB;
constexpr size_t WS_D = WS_H;
constexpr size_t WS_XB = 410 * MiB;
constexpr size_t WS_BAR = 506 * MiB;
constexpr size_t WS_END = 507 * MiB;
constexpr size_t WS_PROJ = 146 * MiB;
constexpr size_t WS_OG = 330 * MiB;
constexpr size_t WS_OA = 354 * MiB;
constexpr size_t WS_OB = 362 * MiB;
constexpr size_t WS_Z = 378 * MiB;

#ifndef STOP_AFTER
#define STOP_AFTER 99
#endif
#ifndef SKIP_A
#define SKIP_A 0
#endif
#ifndef SKIP_B
#define SKIP_B 0
#endif
constexpr int LDS_BYTES = 131072 + 16384;

typedef float f32x2_t __attribute__((ext_vector_type(2))); typedef __bf16 bf16x2_t __attribute__((ext_vector_type(2)));
__device__ __forceinline__ unsigned cvt_pk_bf16(float lo, float hi) { f32x2_t v = {lo, hi}; bf16x2_t b = __builtin_convertvector(v, bf16x2_t); return __builtin_bit_cast(unsigned, b); }
__device__ __forceinline__ float bf_lo(unsigned u) { return __uint_as_float(u << 16); }
__device__ __forceinline__ float bf_hi(unsigned u) { return __uint_as_float(u & 0xffff0000u); }
__device__ __forceinline__ float fexp2(float x) { return __builtin_amdgcn_exp2f(x); }
__device__ __forceinline__ float frcp(float x) { return __builtin_amdgcn_rcpf(x); }
__device__ __forceinline__ float sigmoidf_(float x) { return frcp(1.0f + fexp2(-x * LOG2E)); }
__device__ __forceinline__ float wave_sum(float v) {
#pragma unroll
    for (int o = 1; o < 64; o <<= 1) v += __shfl_xor(v, o);
    return v;
}

namespace pg8 {
constexpr int BM = 256, BK = 64, HALF = 128, HTB = HALF * BK * 2, STAGE_BYTES = 8 * HTB, NXCD = 8, WGM = 8;
__host__ __device__ __forceinline__ int lds_byte(int r, int c) { const int st = (r >> 4) * 2 + (c >> 5), rr = r & 15, cc = c & 31, ob = rr * 64 + cc * 2; return st * 1024 + (ob ^ (((ob >> 9) & 1) << 5)); }
__host__ __device__ __forceinline__ void stage_rc(int b, int& R, int& C) { const int st = b / 1024, sb = b % 1024, swz = sb ^ (((sb >> 9) & 1) << 5); R = (st >> 1) * 16 + swz / 64; C = (st & 1) * 32 + (swz % 64) / 2; }
__host__ __device__ __forceinline__ int perm32(int rho) { const int n = rho >> 4, i = rho & 15; return 8 * (i >> 2) + 4 * n + (i & 3); }

struct Unit { int pm, pn; };
struct Gemm { const bf16_t* A; const bf16_t* Bt; int M, N, K; };

struct StaticOrder {
    int nM, nN, nwg, G, c;
    __device__ void init(int M, int N, int G_, int c_) { nM = M / BM; nN = N / BM; nwg = nM * nN; G = G_; c = c_; }
    __device__ bool next(int i, Unit& u) const {
        const long L = (long)i * G + c; if (L >= nwg) return false;
        int wgid = (int)L; { const int q = nwg / NXCD, r = nwg % NXCD, xcd = wgid % NXCD, off = wgid / NXCD; wgid = (xcd < r ? xcd * (q + 1) : r * (q + 1) + (xcd - r) * q) + off; }
        const int nig = WGM * nN, gid = wgid / nig, fm = gid * WGM, gsz = (nM - fm) < WGM ? (nM - fm) : WGM;
        u.pm = fm + ((wgid % nig) % gsz); u.pn = (wgid % nig) / gsz; return true;
    }
};

template <class Epi>
__device__ __forceinline__ void gemm_phase(LAS unsigned char* lds, const Gemm g, const StaticOrder& S, const Epi& E) {
    int tid_ = threadIdx.x; asm volatile("" : "+v"(tid_));
    const int tid = tid_, wid = __builtin_amdgcn_readfirstlane(tid >> 6), lane = tid & 63, wr = wid >> 2, wc = wid & 3, fr = lane & 15, fq = lane >> 4;
    const int K = g.K, nt = K / BK;
    unsigned voffA[2], voffB[2];
#pragma unroll
    for (int i = 0; i < 2; ++i) { int R, C; stage_rc(tid * 16 + i * 8192, R, C); const int Rb = (R & ~31) + perm32(R & 31);
        voffA[i] = (unsigned)(R * K + C) * 2u; voffB[i] = (unsigned)(Rb * K + C) * 2u; }
    const size_t kstep = (size_t)(BK * 2);
    const size_t hstep = (size_t)HALF * K * 2;
    const size_t tstep = 2 * hstep;
    const unsigned ldsw = (unsigned)wid * 1024u;
    const int aoff = lds_byte(wr * 64 + fr, fq * 8), boff = lds_byte(wc * 32 + fr, fq * 8);
#define PG8_SA(b, h) (((b) * 2 + (h)) * HTB)
#define PG8_SB(b, h) ((4 + (b) * 2 + (h)) * HTB)
#define PG8_STAGE(bufoff, gbase, voff) do { _Pragma("unroll") for (int _i = 0; _i < 2; ++_i) \
        __builtin_amdgcn_global_load_lds((const __attribute__((address_space(1))) unsigned*)((const char*)(gbase) + (voff)[_i]), (LAS unsigned*)(lds + (bufoff) + ldsw + _i * 8192), 16, 0, 0); } while (0)
#define PG8_LDA(dst, b, h) do { _Pragma("unroll") for (int m = 0; m < 4; ++m) _Pragma("unroll") for (int k = 0; k < 2; ++k) dst[m][k] = *(const LAS bf16x8*)(lds + PG8_SA(b, h) + aoff + m * 2048 + k * 1024); } while (0)
#define PG8_LDB(dst, b, h) do { _Pragma("unroll") for (int n = 0; n < 2; ++n) _Pragma("unroll") for (int k = 0; k < 2; ++k) dst[n][k] = *(const LAS bf16x8*)(lds + PG8_SB(b, h) + boff + n * 2048 + k * 1024); } while (0)
#define PG8_MMA(ai, bj, At, Bt) do { __builtin_amdgcn_s_setprio(1); _Pragma("unroll") for (int m = 0; m < 4; ++m) _Pragma("unroll") for (int n = 0; n < 2; ++n) _Pragma("unroll") for (int k = 0; k < 2; ++k) \
        acc[ai][bj][m][n] = __builtin_amdgcn_mfma_f32_16x16x32_bf16(Bt[n][k], At[m][k], acc[ai][bj][m][n], 0, 0, 0); __builtin_amdgcn_s_setprio(0); } while (0)
#define PG8_WAIT_V(n) asm volatile("s_waitcnt vmcnt(" #n ")" ::: "memory")
#define PG8_WAIT_L(n) asm volatile("s_waitcnt lgkmcnt(" #n ")" ::: "memory")
#define PG8_BAR __builtin_amdgcn_s_barrier()
#define PG8_SCHED __builtin_amdgcn_sched_barrier(0)
    Unit cur, nxt; int ui = 0;
    if (!S.next(0, cur)) return;
    f32x4 acc[2][2][4][2];
#pragma unroll
    for (int a = 0; a < 2; ++a)
#pragma unroll
        for (int b = 0; b < 2; ++b)
#pragma unroll
            for (int m = 0; m < 4; ++m)
#pragma unroll
                for (int n = 0; n < 2; ++n) acc[a][b][m][n] = (f32x4){0.f, 0.f, 0.f, 0.f};
    bf16x8 At[4][2], B0[2][2], B1[2][2];
    const char* cA = (const char*)g.A + (size_t)cur.pm * tstep; const char* cB = (const char*)g.Bt + (size_t)cur.pn * tstep;
    PG8_STAGE(PG8_SB(0, 0), cB, voffB); PG8_STAGE(PG8_SB(0, 1), cB + hstep, voffB); PG8_STAGE(PG8_SA(0, 0), cA, voffA); PG8_STAGE(PG8_SA(0, 1), cA + hstep, voffA);
    if (wr == 1) PG8_BAR;
    PG8_WAIT_V(2); PG8_BAR;
    PG8_STAGE(PG8_SB(1, 0), cB + kstep, voffB); PG8_STAGE(PG8_SA(1, 0), cA + kstep, voffA); PG8_STAGE(PG8_SB(1, 1), cB + hstep + kstep, voffB);
    PG8_WAIT_V(6); PG8_BAR;
    for (;;) {
        const bool has_next = S.next(ui + 1, nxt);
        const char* nA = has_next ? (const char*)g.A + (size_t)nxt.pm * tstep : cA; const char* nB = has_next ? (const char*)g.Bt + (size_t)nxt.pn * tstep : cB;
#pragma nounroll
        for (int t = 0; t < nt; t += 2) {
            const bool last = (t == nt - 2);
            const char* a1 = cA + (size_t)(t + 1) * kstep;
            const char* a2 = last ? nA : cA + (size_t)(t + 2) * kstep; const char* b2 = last ? nB : cB + (size_t)(t + 2) * kstep;
            const char* a3 = a2 + kstep; const char* b3 = b2 + kstep;
            PG8_LDB(B0, 0, 0); PG8_LDB(B1, 0, 1); PG8_SCHED; PG8_LDA(At, 0, 0); PG8_STAGE(PG8_SA(1, 1), a1 + hstep, voffA);
            PG8_WAIT_V(8); PG8_WAIT_L(0); PG8_BAR; PG8_MMA(0, 0, At, B0); PG8_MMA(0, 1, At, B1); PG8_BAR; PG8_SCHED;
            PG8_LDA(At, 0, 1); PG8_STAGE(PG8_SB(0, 0), b2, voffB); PG8_STAGE(PG8_SB(0, 1), b2 + hstep, voffB); PG8_STAGE(PG8_SA(0, 0), a2, voffA);
            PG8_WAIT_V(8); PG8_WAIT_L(0); PG8_BAR; PG8_MMA(1, 0, At, B0); PG8_MMA(1, 1, At, B1); PG8_BAR; PG8_SCHED;
            PG8_LDB(B0, 1, 0); PG8_LDB(B1, 1, 1); PG8_SCHED; PG8_LDA(At, 1, 0); PG8_STAGE(PG8_SA(0, 1), a2 + hstep, voffA);
            PG8_WAIT_V(8); PG8_WAIT_L(0); PG8_BAR; PG8_MMA(0, 0, At, B0); PG8_MMA(0, 1, At, B1); PG8_BAR; PG8_SCHED;
            PG8_LDA(At, 1, 1); PG8_STAGE(PG8_SB(1, 0), b3, voffB); PG8_STAGE(PG8_SB(1, 1), b3 + hstep, voffB); PG8_STAGE(PG8_SA(1, 0), a3, voffA);
            PG8_WAIT_V(8); PG8_WAIT_L(0); PG8_BAR; PG8_MMA(1, 0, At, B0); PG8_MMA(1, 1, At, B1); PG8_BAR; PG8_SCHED;
        }
        if (wr == 0) PG8_BAR;
        E(acc, cur, wr, wc, fr, fq);
        if (!has_next) break;
#pragma unroll
        for (int a = 0; a < 2; ++a)
#pragma unroll
            for (int b = 0; b < 2; ++b)
#pragma unroll
                for (int m = 0; m < 4; ++m)
#pragma unroll
                    for (int n = 0; n < 2; ++n) acc[a][b][m][n] = (f32x4){0.f, 0.f, 0.f, 0.f};
        cur = nxt; cA = nA; cB = nB; ++ui;
        if (wr == 1) PG8_BAR;
    }
    PG8_WAIT_V(0);
    PG8_BAR;
#undef PG8_SA
#undef PG8_SB
#undef PG8_STAGE
#undef PG8_LDA
#undef PG8_LDB
#undef PG8_MMA
#undef PG8_WAIT_V
#undef PG8_WAIT_L
#undef PG8_BAR
#undef PG8_SCHED
}
}
using pg8::Unit;

typedef f32x4 AccT[2][2][4][2];

#define OPAQUE(o) asm volatile("" : "+v"(o))
struct EpiPlain {
    bf16_t* O; int ldc;
    __device__ __forceinline__ void operator()(const AccT& acc, const Unit& u, int wr, int wc, int fr, int fq) const {
        const unsigned lo = (unsigned)((u.pm * 256 + wr * 64 + fr) * ldc + u.pn * 256 + wc * 32 + 8 * fq) * 2u;
#pragma unroll
        for (int ai = 0; ai < 2; ++ai)
#pragma unroll
            for (int m = 0; m < 4; ++m) { unsigned o = lo + (unsigned)((ai * 128 + m * 16) * ldc) * 2u; OPAQUE(o); char* rowp = (char*)O + o;
#pragma unroll
                for (int bj = 0; bj < 2; ++bj) { const f32x4 v0 = acc[ai][bj][m][0], v1 = acc[ai][bj][m][1];
                    u32x4 w; w.x = cvt_pk_bf16(v0[0], v0[1]); w.y = cvt_pk_bf16(v0[2], v0[3]); w.z = cvt_pk_bf16(v1[0], v1[1]); w.w = cvt_pk_bf16(v1[2], v1[3]);
                    *(u32x4*)(rowp + bj * 256) = w; } }
    }
};
struct EpiSwiglu {
    bf16_t* O;
    __device__ __forceinline__ void operator()(const AccT& acc, const Unit& u, int wr, int wc, int fr, int fq) const {
        const unsigned lo = (unsigned)((u.pm * 256 + wr * 64 + fr) * FF + u.pn * 128 + wc * 32 + 8 * fq) * 2u;
#pragma unroll
        for (int ai = 0; ai < 2; ++ai)
#pragma unroll
            for (int m = 0; m < 4; ++m) { unsigned o = lo + (unsigned)((ai * 128 + m * 16) * FF) * 2u; OPAQUE(o); char* rowp = (char*)O + o;
                float r[8];
#pragma unroll
                for (int n = 0; n < 2; ++n)
#pragma unroll
                    for (int j = 0; j < 4; ++j) { const float gt = acc[ai][0][m][n][j], up = acc[ai][1][m][n][j]; r[n * 4 + j] = gt * sigmoidf_(gt) * up; }
                u32x4 w; w.x = cvt_pk_bf16(r[0], r[1]); w.y = cvt_pk_bf16(r[2], r[3]); w.z = cvt_pk_bf16(r[4], r[5]); w.w = cvt_pk_bf16(r[6], r[7]);
                *(u32x4*)rowp = w; }
    }
};
struct EpiProj {
    bf16_t* O; const float* rope; const float* bgate; int posmask;
    __device__ __forceinline__ void operator()(const AccT& acc, const Unit& u, int wr, int wc, int fr, int fq) const {
        const int pn = u.pn;
        const int row0 = u.pm * 256 + wr * 64 + fr, col0 = pn * 256 + wc * 32 + 8 * fq;
        const unsigned lo = (unsigned)(row0 * INW + col0) * 2u;
        const bool ropeTile = pn < 6, gateTile = pn >= 15;
        const float sc = (pn < 3 || pn == 9 || pn == 10) ? QSCALE : 1.0f;
        const bool rot = ropeTile && ((wc & 1) == 0) && (fq < 2);
        if (gateTile) {
#pragma unroll
            for (int bj = 0; bj < 2; ++bj) { const f32x4 b0 = *(const f32x4*)(bgate + col0 - GOFF + bj * 128), b1 = *(const f32x4*)(bgate + col0 - GOFF + bj * 128 + 4);
#pragma unroll
                for (int ai = 0; ai < 2; ++ai)
#pragma unroll
                    for (int m = 0; m < 4; ++m) { unsigned o = lo + (unsigned)((ai * 128 + m * 16) * INW) * 2u + bj * 256; OPAQUE(o);
                        f32x4 v0 = acc[ai][bj][m][0] + b0, v1 = acc[ai][bj][m][1] + b1;
#pragma unroll
                        for (int j = 0; j < 4; ++j) { v0[j] = sigmoidf_(v0[j]); v1[j] = sigmoidf_(v1[j]); }
                        u32x4 w; w.x = cvt_pk_bf16(v0[0], v0[1]); w.y = cvt_pk_bf16(v0[2], v0[3]); w.z = cvt_pk_bf16(v1[0], v1[1]); w.w = cvt_pk_bf16(v1[2], v1[3]);
                        *(u32x4*)((char*)O + o) = w; } }
        } else {
#pragma unroll
            for (int ai = 0; ai < 2; ++ai)
#pragma unroll
                for (int m = 0; m < 4; ++m) { unsigned o = lo + (unsigned)((ai * 128 + m * 16) * INW) * 2u; OPAQUE(o);
                    f32x4 cs = (f32x4){1.f, 1.f, 1.f, 1.f}, sn = (f32x4){0.f, 0.f, 0.f, 0.f};
                    if (rot) { unsigned ro = (unsigned)(((row0 + ai * 128 + m * 16) & posmask) * 16 + 4 * fq) * 4u; OPAQUE(ro); cs = *(const f32x4*)((const char*)rope + ro); sn = *(const f32x4*)((const char*)rope + ro + 32); }
#pragma unroll
                    for (int bj = 0; bj < 2; ++bj) { f32x4 v0 = acc[ai][bj][m][0], v1 = acc[ai][bj][m][1];
                        if (ropeTile) { const f32x4 x1 = v0, x2 = v1; v0 = x1 * cs - x2 * sn; v1 = x2 * cs + x1 * sn; }
                        v0 = v0 * sc; v1 = v1 * sc;
                        u32x4 w; w.x = cvt_pk_bf16(v0[0], v0[1]); w.y = cvt_pk_bf16(v0[2], v0[3]); w.z = cvt_pk_bf16(v1[0], v1[1]); w.w = cvt_pk_bf16(v1[2], v1[3]);
                        *(u32x4*)((char*)O + o + bj * 256) = w; }
                    asm volatile("" ::: "memory"); }
        }
    }
};
template <bool ADD> struct EpiGate {
    bf16_t* Z; const bf16_t* P; int goff;
    __device__ __forceinline__ void operator()(const AccT& acc, const Unit& u, int wr, int wc, int fr, int fq) const {
        const int row0 = u.pm * 256 + wr * 64 + fr, col0 = u.pn * 256 + wc * 32 + 8 * fq;
        const unsigned zl = (unsigned)(row0 * DM + col0) * 2u, gl = (unsigned)(row0 * INW + goff + col0) * 2u;
#pragma unroll
        for (int ai = 0; ai < 2; ++ai)
#pragma unroll
            for (int m = 0; m < 4; ++m) {
                unsigned zo_ = zl + (unsigned)((ai * 128 + m * 16) * DM) * 2u, go_ = gl + (unsigned)((ai * 128 + m * 16) * INW) * 2u; OPAQUE(zo_); OPAQUE(go_);
                char* zp = (char*)Z + zo_; const char* gp = (const char*)P + go_;
#pragma unroll
                for (int bj = 0; bj < 2; ++bj) { const f32x4 v0 = acc[ai][bj][m][0], v1 = acc[ai][bj][m][1];
                    const u32x4 gw = *(const u32x4*)(gp + bj * 256);
                    float r[8];
                    r[0] = bf_lo(gw.x) * v0[0]; r[1] = bf_hi(gw.x) * v0[1]; r[2] = bf_lo(gw.y) * v0[2]; r[3] = bf_hi(gw.y) * v0[3];
                    r[4] = bf_lo(gw.z) * v1[0]; r[5] = bf_hi(gw.z) * v1[1]; r[6] = bf_lo(gw.w) * v1[2]; r[7] = bf_hi(gw.w) * v1[3];
                    if (ADD) { const u32x4 zo = *(const u32x4*)(zp + bj * 256);
                        r[0] += bf_lo(zo.x); r[1] += bf_hi(zo.x); r[2] += bf_lo(zo.y); r[3] += bf_hi(zo.y); r[4] += bf_lo(zo.z); r[5] += bf_hi(zo.z); r[6] += bf_lo(zo.w); r[7] += bf_hi(zo.w); }
                    u32x4 w; w.x = cvt_pk_bf16(r[0], r[1]); w.y = cvt_pk_bf16(r[2], r[3]); w.z = cvt_pk_bf16(r[4], r[5]); w.w = cvt_pk_bf16(r[6], r[7]);
                    *(u32x4*)(zp + bj * 256) = w; }
                asm volatile("" ::: "memory"); }
    }
};

struct Args {
    const float* in[20];
    float* out;
    unsigned char* ws;
};

__device__ __forceinline__ void transpose_item(const float* W, int ldw, int sc, bf16_t* WT, int K, int n0, int k0, LAS float* scr, int lane) {
#pragma unroll 8
    for (int i = 0; i < 32; ++i) { const int kk = 2 * i + (lane >> 5); scr[kk * 33 + (lane & 31)] = W[(size_t)(k0 + kk) * ldw + sc]; }
    asm volatile("s_waitcnt lgkmcnt(0)" ::: "memory");
    const int c = lane & 7;
#pragma unroll
    for (int j = 0; j < 4; ++j) { const int n = (lane >> 3) + 8 * j; const LAS float* s = scr + (8 * c) * 33 + n;
        u32x4 o; o.x = cvt_pk_bf16(s[0 * 33], s[1 * 33]); o.y = cvt_pk_bf16(s[2 * 33], s[3 * 33]); o.z = cvt_pk_bf16(s[4 * 33], s[5 * 33]); o.w = cvt_pk_bf16(s[6 * 33], s[7 * 33]);
        *(u32x4*)(WT + (size_t)(n0 + n) * K + k0 + 8 * c) = o; }
    asm volatile("s_waitcnt lgkmcnt(0)" ::: "memory");
}
template <int KIND>
__device__ __forceinline__ void transpose_items(const float* W0, const float* W1, int ldw, bf16_t* WT, int K, int N, LAS float* scr, int lane, int gw, int NGW) {
    const int nblk = N / 32, nitems = (K / 64) * nblk;
    for (int it = gw; it < nitems; it += NGW) {
        const int kb = it / nblk, nb = it % nblk, n0 = nb * 32, n = n0 + (lane & 31);
        const float* W = W0; int sc = n;
        if (KIND == 1) { const int tile = n >> 8, bj = (n >> 7) & 1, j = n & 127; W = bj ? W1 : W0; sc = tile * 128 + j; }
        if (KIND == 2) { if (n < 1536 && (n & 63) < 16) { const int p = n & 15; const int d = (p < 8) ? ((p & 3) + ((p >> 2) << 3)) : (4 + (p & 3) + (((p - 8) >> 2) << 3)); sc = (n & ~15) + d; } }
        transpose_item(W, ldw, sc, WT, K, n0, kb * 64, scr, lane);
    }
}

template <bool HAS_D, bool HAS_H, bool XIN16, bool XOUT16>
__device__ __forceinline__ void row_pass(const float* xa, const float* xb, const bf16_t* x16in, const bf16_t* D, const float* gpost, float dscale, float* xout, bf16_t* x16out, const float* gpre, bf16_t* hout, int lane, int gw, int NGW) {
    f32x4 gp[4], gq[4];
#pragma unroll
    for (int j = 0; j < 4; ++j) { if (HAS_D) gp[j] = *(const f32x4*)(gpost + 4 * lane + 256 * j); if (HAS_H) gq[j] = *(const f32x4*)(gpre + 4 * lane + 256 * j); }
    for (int row = gw; row < TALL; row += NGW) {
        f32x4 v[4];
        if (XIN16) {
#pragma unroll
            for (int j = 0; j < 4; ++j) { const u32x2 w = *(const u32x2*)(x16in + (size_t)row * DM + 4 * lane + 256 * j); v[j] = (f32x4){bf_lo(w.x), bf_hi(w.x), bf_lo(w.y), bf_hi(w.y)}; }
        } else {
            const float* xr = (row < TP) ? xa + (size_t)row * DM : xb + (size_t)(row - TP) * DM;
#pragma unroll
            for (int j = 0; j < 4; ++j) v[j] = *(const f32x4*)(xr + 4 * lane + 256 * j);
        }
        if (HAS_D) {
            f32x4 d[4]; float ss = 0.f;
#pragma unroll
            for (int j = 0; j < 4; ++j) { const u32x2 w = *(const u32x2*)(D + (size_t)row * DM + 4 * lane + 256 * j);
                d[j] = (f32x4){bf_lo(w.x), bf_hi(w.x), bf_lo(w.y), bf_hi(w.y)}; ss += (d[j][0] * d[j][0] + d[j][1] * d[j][1]) + (d[j][2] * d[j][2] + d[j][3] * d[j][3]); }
            const float r = dscale * __builtin_amdgcn_rsqf(wave_sum(ss) * (1.0f / DM) + RMS_EPS);
#pragma unroll
            for (int j = 0; j < 4; ++j) { v[j] = v[j] + d[j] * gp[j] * r;
                if (XOUT16) { u32x2 w; w.x = cvt_pk_bf16(v[j][0], v[j][1]); w.y = cvt_pk_bf16(v[j][2], v[j][3]); *(u32x2*)(x16out + (size_t)row * DM + 4 * lane + 256 * j) = w; }
                else *(f32x4*)(xout + (size_t)row * DM + 4 * lane + 256 * j) = v[j]; }
        }
        if (HAS_H) {
            float ss = 0.f;
#pragma unroll
            for (int j = 0; j < 4; ++j) ss += (v[j][0] * v[j][0] + v[j][1] * v[j][1]) + (v[j][2] * v[j][2] + v[j][3] * v[j][3]);
            const float r = __builtin_amdgcn_rsqf(wave_sum(ss) * (1.0f / DM) + RMS_EPS);
#pragma unroll
            for (int j = 0; j < 4; ++j) { const f32x4 o = v[j] * gq[j] * r; u32x2 w; w.x = cvt_pk_bf16(o[0], o[1]); w.y = cvt_pk_bf16(o[2], o[3]);
                *(u32x2*)(hout + (size_t)row * DM + 4 * lane + 256 * j) = w; }
        }
    }
}

constexpr int KS = 144;
constexpr int WAVE_LDS = 2 * 32 * KS;
constexpr int RPB_OFF = 81920;
__device__ __forceinline__ int crow(int r, int hi) { return (r & 3) + 8 * (r >> 2) + 4 * hi; }
__device__ __forceinline__ s16x4 vtr(LAS const unsigned char* p) { return __builtin_bit_cast(s16x4, __builtin_amdgcn_ds_read_tr16_b64_v4i16((LAS s16x4*)p)); }

struct KVRegs { u32x4 k[4], v[4]; };

#define ATT_LOAD(R, tokexpr) do { _Pragma("unroll") for (int _i = 0; _i < 4; ++_i) { const int _rowi = (lane >> 3) + 8 * _i; const size_t _tok = (size_t)(tokexpr); \
        const bf16_t* _p = proj + _tok * INW + 8 * (lane & 7); R.k[_i] = *(const u32x4*)(_p + kcol); R.v[_i] = *(const u32x4*)(_p + vcol); } } while (0)
#define ATT_STORE(R) do { _Pragma("unroll") for (int _i = 0; _i < 4; ++_i) { const int _rowi = (lane >> 3) + 8 * _i; \
        *(LAS u32x4*)(wl + _rowi * KS + 16 * (lane & 7)) = R.k[_i]; *(LAS u32x4*)(wl + 32 * KS + _rowi * KS + 16 * (lane & 7)) = R.v[_i]; } } while (0)
#define ATT_QK(s) do { s = (f32x16){0.f,0.f,0.f,0.f,0.f,0.f,0.f,0.f,0.f,0.f,0.f,0.f,0.f,0.f,0.f,0.f}; _Pragma("unroll") for (int _d = 0; _d < 4; ++_d) { \
        const bf16x8 _kf = *(const LAS bf16x8*)(wl + q32 * KS + 32 * _d + 16 * hi); s = __builtin_amdgcn_mfma_f32_32x32x16_bf16(_kf, qr[_d], s, 0, 0, 0); } } while (0)
#define ATT_SOFTMAX_PV(s) do { \
        float _tm = s[0]; _Pragma("unroll") for (int _r = 1; _r < 16; ++_r) _tm = fmaxf(_tm, s[_r]); \
        _tm = fmaxf(_tm, __shfl_xor(_tm, 32)); \
        if (__any(_tm > m_run)) { const float _mn = fmaxf(m_run, _tm), _al = fexp2(m_run - _mn); m_run = _mn; l_run *= _al; \
            _Pragma("unroll") for (int _r = 0; _r < 16; ++_r) { oT0[_r] *= _al; oT1[_r] *= _al; } } \
        float _sum = 0.f; _Pragma("unroll") for (int _r = 0; _r < 16; ++_r) { s[_r] = fexp2(s[_r] - m_run); _sum += s[_r]; } \
        l_run += _sum; \
        u32x4 _p0, _p1; _p0.x = cvt_pk_bf16(s[0], s[1]); _p0.y = cvt_pk_bf16(s[2], s[3]); _p0.z = cvt_pk_bf16(s[4], s[5]); _p0.w = cvt_pk_bf16(s[6], s[7]); \
        _p1.x = cvt_pk_bf16(s[8], s[9]); _p1.y = cvt_pk_bf16(s[10], s[11]); _p1.z = cvt_pk_bf16(s[12], s[13]); _p1.w = cvt_pk_bf16(s[14], s[15]); \
        const bf16x8 _pb0 = __builtin_bit_cast(bf16x8, _p0), _pb1 = __builtin_bit_cast(bf16x8, _p1); \
        { const s16x4 a = vtr(vtb), b = vtr(vtb + 8 * KS); const bf16x8 vf = (bf16x8){a[0], a[1], a[2], a[3], b[0], b[1], b[2], b[3]}; oT0 = __builtin_amdgcn_mfma_f32_32x32x16_bf16(vf, _pb0, oT0, 0, 0, 0); } \
        { const s16x4 a = vtr(vtb + 16 * KS), b = vtr(vtb + 24 * KS); const bf16x8 vf = (bf16x8){a[0], a[1], a[2], a[3], b[0], b[1], b[2], b[3]}; oT0 = __builtin_amdgcn_mfma_f32_32x32x16_bf16(vf, _pb1, oT0, 0, 0, 0); } \
        { const s16x4 a = vtr(vtb + 64), b = vtr(vtb + 64 + 8 * KS); const bf16x8 vf = (bf16x8){a[0], a[1], a[2], a[3], b[0], b[1], b[2], b[3]}; oT1 = __builtin_amdgcn_mfma_f32_32x32x16_bf16(vf, _pb0, oT1, 0, 0, 0); } \
        { const s16x4 a = vtr(vtb + 64 + 16 * KS), b = vtr(vtb + 64 + 24 * KS); const bf16x8 vf = (bf16x8){a[0], a[1], a[2], a[3], b[0], b[1], b[2], b[3]}; oT1 = __builtin_amdgcn_mfma_f32_32x32x16_bf16(vf, _pb1, oT1, 0, 0, 0); } \
    } while (0)
#define ATT_WRITE_O(orow) do { \
        _Pragma("unroll") for (int _g = 0; _g < 4; ++_g) { \
            u32x2 w0, w1; w0.x = cvt_pk_bf16(oT0[4 * _g] * inv, oT0[4 * _g + 1] * inv); w0.y = cvt_pk_bf16(oT0[4 * _g + 2] * inv, oT0[4 * _g + 3] * inv); \
            w1.x = cvt_pk_bf16(oT1[4 * _g] * inv, oT1[4 * _g + 1] * inv); w1.y = cvt_pk_bf16(oT1[4 * _g + 2] * inv, oT1[4 * _g + 3] * inv); \
            *(u32x2*)((orow) + 8 * _g + 4 * hi) = w0; *(u32x2*)((orow) + 32 + 8 * _g + 4 * hi) = w1; } } while (0)

__device__ __forceinline__ void attnA_unit(int u, const bf16_t* proj, bf16_t* og, float* lse, int S, LAS unsigned char* wl, int lane) {
    const int q32 = lane & 31, hi = lane >> 5;
    const int g = u / 2048, rem = u % 2048, h = rem / 512, idx = rem % 512;
    const int per_seq = S / 32, seq = idx / per_seq, ii = idx % per_seq;
    const int dsh = 2 * g, dl = 1 << dsh;
    const int r = ii & (dl - 1), c = ii >> dsh, L = S >> dsh;
    const int hd = 4 * g + h, qcol = hd * 64, kcol = 768 + hd * 64, vcol = 1536 + hd * 64;
    const size_t seqbase = (size_t)seq * S;
    const int qm = 32 * c + q32;
    const size_t qtok = seqbase + (size_t)qm * dl + r;
    bf16x8 qr[4];
#pragma unroll
    for (int d = 0; d < 4; ++d) qr[d] = *(const bf16x8*)(proj + qtok * INW + qcol + 16 * d + 8 * hi);
    const int m0 = 32 * c - 64;
    LAS const unsigned char* vtb = wl + 32 * KS + (4 * hi + ((lane & 15) >> 2)) * KS + (16 * ((lane >> 4) & 1) + 4 * (lane & 3)) * 2;
    float m_run = -1e29f, l_run = 0.f;
    f32x16 oT0 = (f32x16){0.f,0.f,0.f,0.f,0.f,0.f,0.f,0.f,0.f,0.f,0.f,0.f,0.f,0.f,0.f,0.f}, oT1 = oT0;
    KVRegs Ra, Rb;
#define TOKA(t) (seqbase + (size_t)min(max(m0 + 32 * (t) + _rowi, 0), L - 1) * dl + r)
#define A_TILE(t) do { \
        f32x16 s; ATT_QK(s); \
        const int kb0 = m0 + 32 * (t); \
        if (kb0 < 0 || kb0 + 32 > L) { \
            _Pragma("unroll") for (int rr = 0; rr < 16; ++rr) { const int km = kb0 + crow(rr, hi); const int dk = km - qm; \
                const bool ok = (km >= 0) && (km < L) && (dk <= 64) && (dk >= -64); s[rr] = ok ? s[rr] : NEGBIG; } \
        } else if ((t) == 0) { \
            _Pragma("unroll") for (int rr = 0; rr < 16; ++rr) s[rr] = (crow(rr, hi) >= q32) ? s[rr] : NEGBIG; \
        } else if ((t) == 4) { \
            _Pragma("unroll") for (int rr = 0; rr < 16; ++rr) s[rr] = (crow(rr, hi) <= q32) ? s[rr] : NEGBIG; \
        } \
        ATT_SOFTMAX_PV(s); } while (0)
    ATT_LOAD(Ra, TOKA(0)); ATT_LOAD(Rb, TOKA(1));
    ATT_STORE(Ra); ATT_LOAD(Ra, TOKA(2)); A_TILE(0);
    ATT_STORE(Rb); ATT_LOAD(Rb, TOKA(3)); A_TILE(1);
    ATT_STORE(Ra); ATT_LOAD(Ra, TOKA(4)); A_TILE(2);
    ATT_STORE(Rb); A_TILE(3);
    ATT_STORE(Ra); A_TILE(4);
#undef A_TILE
#undef TOKA
    const float lt = l_run + __shfl_xor(l_run, 32);
    const float inv = frcp(lt);
    bf16_t* orow = og + qtok * 768 + hd * 64;
    ATT_WRITE_O(orow);
    if (hi == 0) lse[qtok * 12 + hd] = m_run + __builtin_amdgcn_logf(lt);
}

__device__ __forceinline__ void attnB_unit(int u, const bf16_t* proj, bf16_t* ob, int S, LAS unsigned char* wl, LAS const float* rpbL, int lane) {
    const int q32 = lane & 31, hi = lane >> 5;
    const int h = u / 512, idx = u % 512;
    const int per_seq = S / 32, seq = idx / per_seq, ii = idx % per_seq;
    const int rp = ii >> 2, cc = ii & 3, rows = S / 64;
    const int ri0 = 2 * rp, qrow = ri0 + (q32 >> 4), qcolg = 16 * cc + (q32 & 15);
    const int qcol = 2304 + h * 64, kcol = 2816 + h * 64, vcol = 3328 + h * 64;
    const size_t seqbase = (size_t)seq * S;
    const size_t qtok = seqbase + (size_t)qrow * 64 + qcolg;
    bf16x8 qr[4];
#pragma unroll
    for (int d = 0; d < 4; ++d) qr[d] = *(const bf16x8*)(proj + qtok * INW + qcol + 16 * d + 8 * hi);
    const int w0 = (cc == 0) ? 0 : (cc == 1) ? 8 : (cc == 2) ? 24 : 32;
    const int rs0 = min(max(ri0 - 4, 0), rows - 8), rs1 = min(max(ri0 - 3, 0), rows - 8);
    const int ntile = rs1 + 8 - rs0;
    const int rsq = min(max(qrow - 4, 0), rows - 8), csq = min(max(qcolg - 8, 0), 48);
    LAS const unsigned char* vtb = wl + 32 * KS + (4 * hi + ((lane & 15) >> 2)) * KS + (16 * ((lane >> 4) & 1) + 4 * (lane & 3)) * 2;
    LAS const float* rb = rpbL + h * 465;
    const unsigned vmaskh = (0xFFFFu << (csq - w0)) >> (4 * hi);
    float m_run = -1e29f, l_run = 0.f;
    f32x16 oT0 = (f32x16){0.f,0.f,0.f,0.f,0.f,0.f,0.f,0.f,0.f,0.f,0.f,0.f,0.f,0.f,0.f,0.f}, oT1 = oT0;
    KVRegs Ra, Rb;
#define TOKB(t) (seqbase + (size_t)(rs0 + (t)) * 64 + w0 + _rowi)
#define B_TILE(t) do { \
        f32x16 s; ATT_QK(s); \
        const int kr = rs0 + (t); \
        const bool rowok = (kr >= rsq) && (kr < rsq + 8); \
        LAS const float* rbt = rb + ((kr - qrow + 7) * 31 + (w0 - qcolg + 15) + 4 * hi); \
        const unsigned mh = rowok ? vmaskh : 0u; \
        _Pragma("unroll") for (int rr = 0; rr < 16; ++rr) { const int ko = (rr & 3) + 8 * (rr >> 2); \
            s[rr] = (mh & (1u << ko)) ? s[rr] + rbt[ko] : NEGBIG; } \
        ATT_SOFTMAX_PV(s); } while (0)
    ATT_LOAD(Ra, TOKB(0)); ATT_LOAD(Rb, TOKB(1));
    for (int t = 0; t < ntile; t += 2) {
        ATT_STORE(Ra); if (t + 2 < ntile) { ATT_LOAD(Ra, TOKB(t + 2)); }
        B_TILE(t);
        if (t + 1 < ntile) {
            ATT_STORE(Rb); if (t + 3 < ntile) { ATT_LOAD(Rb, TOKB(t + 3)); }
            B_TILE(t + 1);
        }
    }
#undef B_TILE
#undef TOKB
    const float lt = l_run + __shfl_xor(l_run, 32);
    const float inv = frcp(lt);
    bf16_t* orow = ob + qtok * 512 + h * 64;
    ATT_WRITE_O(orow);
}


#define XB_TMO      128
#define XB_XCNT(j)  (256  + 64 * (j))
#define XB_XSUB(j)  (1280 + 64 * (j))
#define XB_XGEN(j)  (2304 + 64 * (j))
#define XB_TOP      3328
#define XB_TOPGEN   3392
#define XCD_BAR_WORDS 3456
#define XB_SPIN_CAP (1u << 18)
__device__ __forceinline__ unsigned xb_ld(unsigned* p)              { return __hip_atomic_load(p, __ATOMIC_RELAXED, __HIP_MEMORY_SCOPE_AGENT); }
__device__ __forceinline__ unsigned xb_add(unsigned* p, unsigned v) { return __hip_atomic_fetch_add(p, v, __ATOMIC_RELAXED, __HIP_MEMORY_SCOPE_AGENT); }
__device__ __forceinline__ unsigned xb_xcc_id() { return (unsigned)__builtin_amdgcn_s_getreg((3 << 11) | 20) & 0xFu; }
#define XB_SPIN(cond, bar) do { unsigned _sp = 0; while (cond) { __builtin_amdgcn_s_sleep(1); \
    if ((++_sp & 255u) == 0u) { if (xb_ld(&(bar)[XB_TMO])) break; if (_sp > XB_SPIN_CAP) { atomicAdd(&(bar)[XB_TMO], 1u); break; } } } } while (0)
struct XcdBarrier { unsigned* bar; unsigned x; volatile LAS unsigned* st; };
__device__ __forceinline__ XcdBarrier xcd_barrier_post(unsigned* bar, volatile LAS unsigned* st) {
    XcdBarrier b; b.bar = bar; b.x = xb_xcc_id(); b.st = st;
    if (threadIdx.x == 0) (void)xb_add(&bar[XB_XCNT(b.x)], 1u);
    return b;
}
__device__ __forceinline__ void xcd_barrier_complete(unsigned* bar, unsigned x, unsigned& nloc, unsigned& nx) {
    const unsigned G = gridDim.x * gridDim.y * gridDim.z;
    unsigned sum, cnt, mine, sp = 0u;
    for (;;) {
        sum = 0u; cnt = 0u; mine = 0u;
#pragma unroll
        for (unsigned j = 0; j < 16; ++j) { const unsigned c = xb_ld(&bar[XB_XCNT(j)]); sum += c; cnt += (c > 0u) ? 1u : 0u; mine = (j == x) ? c : mine; }
        if (sum == G) break;
        __builtin_amdgcn_s_sleep(1);
        if ((++sp & 255u) == 0u) { if (xb_ld(&bar[XB_TMO])) break; if (sp > XB_SPIN_CAP) { atomicAdd(&bar[XB_TMO], 1u); break; } }
    }
    nloc = mine > 0u ? mine : 1u; nx = cnt > 0u ? cnt : 1u;
}
__device__ __forceinline__ void xcd_barrier(const XcdBarrier& b) {
    asm volatile("s_waitcnt vmcnt(0)" ::: "memory");
    __syncthreads();
    if (threadIdx.x == 0) {
        unsigned* bar = b.bar;
        __builtin_amdgcn_s_waitcnt(0);
        unsigned nloc = b.st[0], nx = b.st[1];
        if (nloc == 0u) { xcd_barrier_complete(bar, b.x, nloc, nx); b.st[0] = nloc; b.st[1] = nx; }
        const unsigned old = xb_add(&bar[XB_XSUB(b.x)], 1u);
        const unsigned gen = old / nloc;
        if (old + 1u == (gen + 1u) * nloc) {
            __builtin_amdgcn_fence(__ATOMIC_RELEASE, "agent");
            asm volatile("s_waitcnt vmcnt(0)" ::: "memory");
            const unsigned og = xb_add(&bar[XB_TOP], 1u);
            const unsigned tg = og / nx;
            if (og + 1u == (tg + 1u) * nx) xb_add(&bar[XB_TOPGEN], 1u);
            else XB_SPIN(xb_ld(&bar[XB_TOPGEN]) == tg, bar);
            __builtin_amdgcn_fence(__ATOMIC_ACQUIRE, "agent");
            xb_add(&bar[XB_XGEN(b.x)], 1u);
            asm volatile("s_waitcnt vmcnt(0)" ::: "memory");
        } else {
            XB_SPIN(xb_ld(&bar[XB_XGEN(b.x)]) == gen, bar);
            __builtin_amdgcn_fence(__ATOMIC_ACQUIRE, "agent");
            asm volatile("s_waitcnt vmcnt(0)" ::: "memory");
        }
    }
    __syncthreads();
}

#define CGSYNC() do { asm volatile("s_waitcnt vmcnt(0) lgkmcnt(0)" ::: "memory"); grid.sync(); __builtin_amdgcn_fence(__ATOMIC_ACQUIRE, "agent"); asm volatile("s_waitcnt vmcnt(0)" ::: "memory"); } while (0)
#define GSYNC() xcd_barrier(xbar)

template <int CH>
__device__ __forceinline__ void mixer_chunk(const XcdBarrier& xbar, LAS unsigned char* lds, int G, int gw, int NGW, const bf16_t* H, const bf16_t* Win, const bf16_t* Wa, const bf16_t* Wb, const bf16_t* Wout,
        bf16_t* proj, bf16_t* og, float* lse, bf16_t* oa, bf16_t* ob, bf16_t* Z, bf16_t* Dbuf, const float* rope, const float* bgate, const float* rpb) {
    int tid_ = threadIdx.x; asm volatile("" : "+v"(tid_));
    const int tid = tid_, lane = tid & 63, wid = __builtin_amdgcn_readfirstlane(tid >> 6);
    pg8::StaticOrder SO;

        constexpr int ch = CH; constexpr int S = (CH == 0) ? 8192 : 16384;
        const bf16_t* Hc = H + (size_t)ch * TC * DM;
        { pg8::Gemm g{Hc, Win, TC, INW, DM}; SO.init(TC, INW, G, blockIdx.x); EpiProj E{proj, rope, bgate, S - 1}; pg8::gemm_phase(lds, g, SO, E); }
        GSYNC();
        {
            LAS unsigned char* wl = lds + wid * WAVE_LDS;
            for (int u = gw; u < 3 * 4 * (TC / 32); u += NGW) { if (!SKIP_A) attnA_unit(u, proj, og, lse, S, wl, lane); }
        }
        GSYNC();
        {
            LAS float* rpbL = (LAS float*)(lds + RPB_OFF);
            for (int i = tid; i < 8 * 465; i += NTHR) rpbL[i] = rpb[i] * LOG2E;
            __syncthreads();
            LAS unsigned char* wl = lds + wid * WAVE_LDS;
            for (int u = gw; u < 8 * (TC / 32); u += NGW) { if (!SKIP_B) attnB_unit(u, proj, ob, S, wl, rpbL, lane); }
            for (int i = blockIdx.x * NTHR + tid; i < TC * 32; i += G * NTHR) {
                const int tl = i >> 5, h = (i >> 3) & 3, c8 = i & 7;
                const float l0 = lse[tl * 12 + h], l1 = lse[tl * 12 + 4 + h], l2 = lse[tl * 12 + 8 + h];
                const float mx = fmaxf(l0, fmaxf(l1, l2));
                float e0 = fexp2(l0 - mx), e1 = fexp2(l1 - mx), e2 = fexp2(l2 - mx);
                const float is = frcp(e0 + e1 + e2); e0 *= is; e1 *= is; e2 *= is;
                const bf16_t* p = og + (size_t)tl * 768 + h * 64 + c8 * 8;
                const u32x4 v0 = *(const u32x4*)p, v1 = *(const u32x4*)(p + 256), v2 = *(const u32x4*)(p + 512);
                u32x4 w;
                w.x = cvt_pk_bf16(e0 * bf_lo(v0.x) + e1 * bf_lo(v1.x) + e2 * bf_lo(v2.x), e0 * bf_hi(v0.x) + e1 * bf_hi(v1.x) + e2 * bf_hi(v2.x));
                w.y = cvt_pk_bf16(e0 * bf_lo(v0.y) + e1 * bf_lo(v1.y) + e2 * bf_lo(v2.y), e0 * bf_hi(v0.y) + e1 * bf_hi(v1.y) + e2 * bf_hi(v2.y));
                w.z = cvt_pk_bf16(e0 * bf_lo(v0.z) + e1 * bf_lo(v1.z) + e2 * bf_lo(v2.z), e0 * bf_hi(v0.z) + e1 * bf_hi(v1.z) + e2 * bf_hi(v2.z));
                w.w = cvt_pk_bf16(e0 * bf_lo(v0.w) + e1 * bf_lo(v1.w) + e2 * bf_lo(v2.w), e0 * bf_hi(v0.w) + e1 * bf_hi(v1.w) + e2 * bf_hi(v2.w));
                *(u32x4*)(oa + (size_t)tl * 256 + h * 64 + c8 * 8) = w;
            }
        }
        GSYNC();
        { pg8::Gemm g{oa, Wa, TC, DM, 256}; SO.init(TC, DM, G, blockIdx.x); EpiGate<false> E{Z, proj, GOFF}; pg8::gemm_phase(lds, g, SO, E); }
        { pg8::Gemm g{ob, Wb, TC, DM, 512}; SO.init(TC, DM, G, blockIdx.x); EpiGate<true> E{Z, proj, GOFF + DM}; pg8::gemm_phase(lds, g, SO, E); }
        GSYNC();
        { pg8::Gemm g{Z, Wout, TC, DM, DM}; SO.init(TC, DM, G, blockIdx.x); EpiPlain E{Dbuf + (size_t)ch * TC * DM, DM}; pg8::gemm_phase(lds, g, SO, E); }

}

__global__ void __launch_bounds__(NTHR, 2) enc_fwd(Args a) {
    extern __shared__ __attribute__((aligned(16))) unsigned char lds_raw[];
    LAS unsigned char* lds = (LAS unsigned char*)lds_raw;
    cg::grid_group grid = cg::this_grid();
    const int tid = threadIdx.x, lane = tid & 63, wid = __builtin_amdgcn_readfirstlane(tid >> 6);
    const int G = gridDim.x, gw = blockIdx.x * NWAVES + wid, NGW = G * NWAVES;
    unsigned char* ws = a.ws;
    const float* x_p = a.in[0]; const float* x_s = a.in[1];
    bf16_t* Wgu1 = (bf16_t*)(ws + WS_WGU1); bf16_t* Wd1 = (bf16_t*)(ws + WS_WD1); bf16_t* Win = (bf16_t*)(ws + WS_WIN);
    bf16_t* Wa = (bf16_t*)(ws + WS_WA); bf16_t* Wb = (bf16_t*)(ws + WS_WB); bf16_t* Wout = (bf16_t*)(ws + WS_WOUT);
    bf16_t* Wgu2 = (bf16_t*)(ws + WS_WGU2); bf16_t* Wd2 = (bf16_t*)(ws + WS_WD2);
    float* rope = (float*)(ws + WS_ROPE); float* lse = (float*)(ws + WS_LSE);
    bf16_t* H = (bf16_t*)(ws + WS_H); bf16_t* A1 = (bf16_t*)(ws + WS_A1); bf16_t* Dbuf = (bf16_t*)(ws + WS_D); bf16_t* XB = (bf16_t*)(ws + WS_XB);
    bf16_t* proj = (bf16_t*)(ws + WS_PROJ); bf16_t* og = (bf16_t*)(ws + WS_OG); bf16_t* oa = (bf16_t*)(ws + WS_OA); bf16_t* ob = (bf16_t*)(ws + WS_OB); bf16_t* Z = (bf16_t*)(ws + WS_Z);
    float* out = a.out;
    volatile LAS unsigned* xst = (volatile LAS unsigned*)(lds + 131072 + 8192);
    if (tid < 2) xst[tid] = 0u;
    __syncthreads();
    const XcdBarrier xbar = xcd_barrier_post((unsigned*)(ws + WS_BAR), xst);

    {
        LAS float* scr = (LAS float*)(lds + wid * 16384);
        transpose_items<1>(a.in[4], a.in[5], FF, Wgu1, DM, 2 * FF, scr, lane, gw, NGW);
        transpose_items<0>(a.in[6], nullptr, DM, Wd1, FF, DM, scr, lane, gw, NGW);
        transpose_items<2>(a.in[9], nullptr, INW, Win, DM, INW, scr, lane, gw, NGW);
        transpose_items<0>(a.in[12], nullptr, DM, Wa, 256, DM, scr, lane, gw, NGW);
        transpose_items<0>(a.in[13], nullptr, DM, Wb, 512, DM, scr, lane, gw, NGW);
        transpose_items<0>(a.in[14], nullptr, DM, Wout, DM, DM, scr, lane, gw, NGW);
        transpose_items<1>(a.in[17], a.in[18], FF, Wgu2, DM, 2 * FF, scr, lane, gw, NGW);
        transpose_items<0>(a.in[19], nullptr, DM, Wd2, FF, DM, scr, lane, gw, NGW);
        for (int i = blockIdx.x * NTHR + tid; i < 16384 * 8; i += G * NTHR) {
            const int pos = i >> 3, f = i & 7;
            const double invf = (f == 0) ? 1.0 : (f == 1) ? 0.19392274474868576 : (f == 2) ? 0.03760603093086393 : (f == 3) ? 0.007292664737217109 : (f == 4) ? 0.001414213562373095
                              : (f == 5) ? 0.0002742481756762073 : (f == 6) ? 5.318295896944988e-05 : 1.031338537721246e-05;
            const float angf = (float)pos * (float)invf;
            double tt = (double)angf * 0.15915494309189535; tt -= floor(tt);
            const float fr = (float)tt;
            rope[pos * 16 + f] = __builtin_amdgcn_cosf(fr); rope[pos * 16 + 8 + f] = __builtin_amdgcn_sinf(fr);
        }
        row_pass<false, true, false, false>(x_p, x_s, nullptr, nullptr, nullptr, 0.f, nullptr, nullptr, a.in[2], H, lane, gw, NGW);
    }
    CGSYNC();
    pg8::StaticOrder SO;
    { pg8::Gemm g{H, Wgu1, TALL, 2 * FF, DM}; SO.init(TALL, 2 * FF, G, blockIdx.x); EpiSwiglu E{A1}; pg8::gemm_phase(lds, g, SO, E); }
    GSYNC();
    { pg8::Gemm g{A1, Wd1, TALL, DM, FF}; SO.init(TALL, DM, G, blockIdx.x); EpiPlain E{Dbuf, DM}; pg8::gemm_phase(lds, g, SO, E); }
    GSYNC();
    row_pass<true, true, false, true>(x_p, x_s, nullptr, Dbuf, a.in[3], 0.5f, nullptr, XB, a.in[7], H, lane, gw, NGW);
    GSYNC();
    if (STOP_AFTER <= 1) return;
    if (STOP_AFTER <= 1) return;
    mixer_chunk<0>(xbar, lds, G, gw, NGW, H, Win, Wa, Wb, Wout, proj, og, lse, oa, ob, Z, Dbuf, rope, a.in[10], a.in[11]);
    mixer_chunk<1>(xbar, lds, G, gw, NGW, H, Win, Wa, Wb, Wout, proj, og, lse, oa, ob, Z, Dbuf, rope, a.in[10], a.in[11]);
    mixer_chunk<2>(xbar, lds, G, gw, NGW, H, Win, Wa, Wb, Wout, proj, og, lse, oa, ob, Z, Dbuf, rope, a.in[10], a.in[11]);
    GSYNC();
    row_pass<true, true, true, true>(nullptr, nullptr, XB, Dbuf, a.in[8], 1.0f, nullptr, XB, a.in[15], H, lane, gw, NGW);
    GSYNC();
    if (STOP_AFTER <= 2) return;
    if (STOP_AFTER <= 2) return;
    { pg8::Gemm g{H, Wgu2, TALL, 2 * FF, DM}; SO.init(TALL, 2 * FF, G, blockIdx.x); EpiSwiglu E{A1}; pg8::gemm_phase(lds, g, SO, E); }
    GSYNC();
    { pg8::Gemm g{A1, Wd2, TALL, DM, FF}; SO.init(TALL, DM, G, blockIdx.x); EpiPlain E{Dbuf, DM}; pg8::gemm_phase(lds, g, SO, E); }
    GSYNC();
    row_pass<true, false, true, false>(nullptr, nullptr, XB, Dbuf, a.in[16], 0.5f, out, nullptr, nullptr, nullptr, lane, gw, NGW);
}

extern "C" void kernel_launch(void* const* d_in, const int* in_sizes, int n_in, void* d_out, int out_size, void* d_ws, size_t ws_size, hipStream_t stream) {
    static int grid = 0;
    if (grid == 0) {
        if (n_in != 20 || out_size != TALL * DM || ws_size < WS_END) { fprintf(stderr, "kernel_launch: unexpected shapes (n_in %d out %d ws %zu)\n", n_in, out_size, ws_size); grid = -1; return; }
        int dev = 0, cus = 0, per_cu = 0;
        hipGetDevice(&dev);
        hipDeviceGetAttribute(&cus, hipDeviceAttributeMultiprocessorCount, dev);
        hipFuncSetAttribute((const void*)enc_fwd, hipFuncAttributeMaxDynamicSharedMemorySize, LDS_BYTES);
        hipOccupancyMaxActiveBlocksPerMultiprocessor(&per_cu, (const void*)enc_fwd, NTHR, LDS_BYTES);
        if (per_cu < 1) per_cu = 1;
        grid = cus * per_cu;
        (void)hipGetLastError();
    }
    if (grid < 0) return;
    if (hipMemsetAsync((char*)d_ws + WS_BAR, 0, 16384, stream) != hipSuccess) { fprintf(stderr, "memset of barrier words failed\n"); return; }
    Args a{};
    for (int i = 0; i < 20; ++i) a.in[i] = (const float*)d_in[i];
    a.out = (float*)d_out; a.ws = (unsigned char*)d_ws;
    void* args[] = {&a};
    hipError_t e = hipLaunchCooperativeKernel((const void*)enc_fwd, dim3(grid), dim3(NTHR), args, LDS_BYTES, stream);
    if (e != hipSuccess) fprintf(stderr, "cooperative launch failed: %s (grid %d)\n", hipGetErrorString(e), grid);
}
```

```cpp
#include <hip/hip_runtime.h>
#include <hip/hip_cooperative_groups.h>
#include <cstdio>
#include <cstdint>
namespace cg = cooperative_groups;

#define LAS __attribute__((address_space(3)))
typedef unsigned short bf16_t;
typedef short bf16x8 __attribute__((ext_vector_type(8)));
typedef short s16x4 __attribute__((ext_vector_type(4)));
typedef float f32x4 __attribute__((ext_vector_type(4)));
typedef float f32x16 __attribute__((ext_vector_type(16)));
typedef unsigned u32x4 __attribute__((ext_vector_type(4)));
typedef unsigned u32x2 __attribute__((ext_vector_type(2)));

constexpr int DM = 1024, FF = 2816, TALL = 49152, TP = 16384, TC = 16384, NCH = 3;
constexpr int INW = 5888, GOFF = 3840;
constexpr int NWAVES = 8, NTHR = 512;
constexpr float RMS_EPS = 1e-6f;
constexpr float LOG2E = 1.4426950408889634f;
constexpr float QSCALE = 0.125f * LOG2E;
constexpr float NEGBIG = -1e30f;

constexpr size_t MiB = 1u << 20;
constexpr size_t WS_WGU1 = 0, WS_WD1 = 11 * MiB, WS_WIN = 16 * MiB + MiB / 2, WS_WA = 28 * MiB, WS_WB = 28 * MiB + MiB / 2, WS_WOUT = 29 * MiB + MiB / 2,
                 WS_WGU2 = 31 * MiB + MiB / 2, WS_WD2 = 42 * MiB + MiB / 2, WS_ROPE = 48 * MiB, WS_LSE = 49 * MiB;
constexpr size_t WS_H = 50 * MiB;
constexpr size_t WS_A1 = 146 * MiB;
constexpr size_t WS_D = WS_H;
constexpr size_t WS_XB = 410 * MiB;
constexpr size_t WS_BAR = 506 * MiB;
constexpr size_t WS_END = 507 * MiB;
constexpr size_t WS_PROJ = 146 * MiB;
constexpr size_t WS_OG = 330 * MiB;
constexpr size_t WS_OA = 354 * MiB;
constexpr size_t WS_OB = 362 * MiB;
constexpr size_t WS_Z = 378 * MiB;

#ifndef STOP_AFTER
#define STOP_AFTER 99
#endif
#ifndef SKIP_A
#define SKIP_A 0
#endif
#ifndef SKIP_B
#define SKIP_B 0
#endif
constexpr int LDS_BYTES = 131072 + 16384;

typedef float f32x2_t __attribute__((ext_vector_type(2))); typedef __bf16 bf16x2_t __attribute__((ext_vector_type(2)));
__device__ __forceinline__ unsigned cvt_pk_bf16(float lo, float hi) { f32x2_t v = {lo, hi}; bf16x2_t b = __builtin_convertvector(v, bf16x2_t); return __builtin_bit_cast(unsigned, b); }
__device__ __forceinline__ float bf_lo(unsigned u) { return __uint_as_float(u << 16); }
__device__ __forceinline__ float bf_hi(unsigned u) { return __uint_as_float(u & 0xffff0000u); }
__device__ __forceinline__ float fexp2(float x) { return __builtin_amdgcn_exp2f(x); }
__device__ __forceinline__ float frcp(float x) { return __builtin_amdgcn_rcpf(x); }
__device__ __forceinline__ float sigmoidf_(float x) { return frcp(1.0f + fexp2(-x * LOG2E)); }
__device__ __forceinline__ float wave_sum(float v) {
#pragma unroll
    for (int o = 1; o < 64; o <<= 1) v += __shfl_xor(v, o);
    return v;
}

namespace pg8 {
constexpr int BM = 256, BK = 64, HALF = 128, HTB = HALF * BK * 2, STAGE_BYTES = 8 * HTB, NXCD = 8, WGM = 8;
__host__ __device__ __forceinline__ int lds_byte(int r, int c) { const int st = (r >> 4) * 2 + (c >> 5), rr = r & 15, cc = c & 31, ob = rr * 64 + cc * 2; return st * 1024 + (ob ^ (((ob >> 9) & 1) << 5)); }
__host__ __device__ __forceinline__ void stage_rc(int b, int& R, int& C) { const int st = b / 1024, sb = b % 1024, swz = sb ^ (((sb >> 9) & 1) << 5); R = (st >> 1) * 16 + swz / 64; C = (st & 1) * 32 + (swz % 64) / 2; }
__host__ __device__ __forceinline__ int perm32(int rho) { const int n = rho >> 4, i = rho & 15; return 8 * (i >> 2) + 4 * n + (i & 3); }

struct Unit { int pm, pn; };
struct Gemm { const bf16_t* A; const bf16_t* Bt; int M, N, K; };

struct StaticOrder {
    int nM, nN, nwg, G, c;
    __device__ void init(int M, int N, int G_, int c_) { nM = M / BM; nN = N / BM; nwg = nM * nN; G = G_; c = c_; }
    __device__ bool next(int i, Unit& u) const {
        const long L = (long)i * G + c; if (L >= nwg) return false;
        int wgid = (int)L; { const int q = nwg / NXCD, r = nwg % NXCD, xcd = wgid % NXCD, off = wgid / NXCD; wgid = (xcd < r ? xcd * (q + 1) : r * (q + 1) + (xcd - r) * q) + off; }
        const int nig = WGM * nN, gid = wgid / nig, fm = gid * WGM, gsz = (nM - fm) < WGM ? (nM - fm) : WGM;
        u.pm = fm + ((wgid % nig) % gsz); u.pn = (wgid % nig) / gsz; return true;
    }
};

template <class Epi>
__device__ __forceinline__ void gemm_phase(LAS unsigned char* lds, const Gemm g, const StaticOrder& S, const Epi& E) {
    int tid_ = threadIdx.x; asm volatile("" : "+v"(tid_));
    const int tid = tid_, wid = __builtin_amdgcn_readfirstlane(tid >> 6), lane = tid & 63, wr = wid >> 2, wc = wid & 3, fr = lane & 15, fq = lane >> 4;
    const int K = g.K, nt = K / BK;
    unsigned voffA[2], voffB[2];
#pragma unroll
    for (int i = 0; i < 2; ++i) { int R, C; stage_rc(tid * 16 + i * 8192, R, C); const int Rb = (R & ~31) + perm32(R & 31);
        voffA[i] = (unsigned)(R * K + C) * 2u; voffB[i] = (unsigned)(Rb * K + C) * 2u; }
    const size_t kstep = (size_t)(BK * 2);
    const size_t hstep = (size_t)HALF * K * 2;
    const size_t tstep = 2 * hstep;
    const unsigned ldsw = (unsigned)wid * 1024u;
    const int aoff = lds_byte(wr * 64 + fr, fq * 8), boff = lds_byte(wc * 32 + fr, fq * 8);
#define PG8_SA(b, h) (((b) * 2 + (h)) * HTB)
#define PG8_SB(b, h) ((4 + (b) * 2 + (h)) * HTB)
#define PG8_STAGE(bufoff, gbase, voff) do { _Pragma("unroll") for (int _i = 0; _i < 2; ++_i) \
        __builtin_amdgcn_global_load_lds((const __attribute__((address_space(1))) unsigned*)((const char*)(gbase) + (voff)[_i]), (LAS unsigned*)(lds + (bufoff) + ldsw + _i * 8192), 16, 0, 0); } while (0)
#define PG8_LDA(dst, b, h) do { _Pragma("unroll") for (int m = 0; m < 4; ++m) _Pragma("unroll") for (int k = 0; k < 2; ++k) dst[m][k] = *(const LAS bf16x8*)(lds + PG8_SA(b, h) + aoff + m * 2048 + k * 1024); } while (0)
#define PG8_LDB(dst, b, h) do { _Pragma("unroll") for (int n = 0; n < 2; ++n) _Pragma("unroll") for (int k = 0; k < 2; ++k) dst[n][k] = *(const LAS bf16x8*)(lds + PG8_SB(b, h) + boff + n * 2048 + k * 1024); } while (0)
#define PG8_MMA(ai, bj, At, Bt) do { __builtin_amdgcn_s_setprio(1); _Pragma("unroll") for (int m = 0; m < 4; ++m) _Pragma("unroll") for (int n = 0; n < 2; ++n) _Pragma("unroll") for (int k = 0; k < 2; ++k) \
        acc[ai][bj][m][n] = __builtin_amdgcn_mfma_f32_16x16x32_bf16(Bt[n][k], At[m][k], acc[ai][bj][m][n], 0, 0, 0); __builtin_amdgcn_s_setprio(0); } while (0)
#define PG8_WAIT_V(n) asm volatile("s_waitcnt vmcnt(" #n ")" ::: "memory")
#define PG8_WAIT_L(n) asm volatile("s_waitcnt lgkmcnt(" #n ")" ::: "memory")
#define PG8_BAR __builtin_amdgcn_s_barrier()
#define PG8_SCHED __builtin_amdgcn_sched_barrier(0)
    Unit cur, nxt; int ui = 0;
    if (!S.next(0, cur)) return;
    f32x4 acc[2][2][4][2];
#pragma unroll
    for (int a = 0; a < 2; ++a)
#pragma unroll
        for (int b = 0; b < 2; ++b)
#pragma unroll
            for (int m = 0; m < 4; ++m)
#pragma unroll
                for (int n = 0; n < 2; ++n) acc[a][b][m][n] = (f32x4){0.f, 0.f, 0.f, 0.f};
    bf16x8 At[4][2], B0[2][2], B1[2][2];
    const char* cA = (const char*)g.A + (size_t)cur.pm * tstep; const char* cB = (const char*)g.Bt + (size_t)cur.pn * tstep;
    PG8_STAGE(PG8_SB(0, 0), cB, voffB); PG8_STAGE(PG8_SB(0, 1), cB + hstep, voffB); PG8_STAGE(PG8_SA(0, 0), cA, voffA); PG8_STAGE(PG8_SA(0, 1), cA + hstep, voffA);
    if (wr == 1) PG8_BAR;
    PG8_WAIT_V(2); PG8_BAR;
    PG8_STAGE(PG8_SB(1, 0), cB + kstep, voffB); PG8_STAGE(PG8_SA(1, 0), cA + kstep, voffA); PG8_STAGE(PG8_SB(1, 1), cB + hstep + kstep, voffB);
    PG8_WAIT_V(6); PG8_BAR;
    for (;;) {
        const bool has_next = S.next(ui + 1, nxt);
        const char* nA = has_next ? (const char*)g.A + (size_t)nxt.pm * tstep : cA; const char* nB = has_next ? (const char*)g.Bt + (size_t)nxt.pn * tstep : cB;
#pragma nounroll
        for (int t = 0; t < nt; t += 2) {
            const bool last = (t == nt - 2);
            const char* a1 = cA + (size_t)(t + 1) * kstep;
            const char* a2 = last ? nA : cA + (size_t)(t + 2) * kstep; const char* b2 = last ? nB : cB + (size_t)(t + 2) * kstep;
            const char* a3 = a2 + kstep; const char* b3 = b2 + kstep;
            PG8_LDB(B0, 0, 0); PG8_LDB(B1, 0, 1); PG8_SCHED; PG8_LDA(At, 0, 0); PG8_STAGE(PG8_SA(1, 1), a1 + hstep, voffA);
            PG8_WAIT_V(8); PG8_WAIT_L(0); PG8_BAR; PG8_MMA(0, 0, At, B0); PG8_MMA(0, 1, At, B1); PG8_BAR; PG8_SCHED;
            PG8_LDA(At, 0, 1); PG8_STAGE(PG8_SB(0, 0), b2, voffB); PG8_STAGE(PG8_SB(0, 1), b2 + hstep, voffB); PG8_STAGE(PG8_SA(0, 0), a2, voffA);
            PG8_WAIT_V(8); PG8_WAIT_L(0); PG8_BAR; PG8_MMA(1, 0, At, B0); PG8_MMA(1, 1, At, B1); PG8_BAR; PG8_SCHED;
            PG8_LDB(B0, 1, 0); PG8_LDB(B1, 1, 1); PG8_SCHED; PG8_LDA(At, 1, 0); PG8_STAGE(PG8_SA(0, 1), a2 + hstep, voffA);
            PG8_WAIT_V(8); PG8_WAIT_L(0); PG8_BAR; PG8_MMA(0, 0, At, B0); PG8_MMA(0, 1, At, B1); PG8_BAR; PG8_SCHED;
            PG8_LDA(At, 1, 1); PG8_STAGE(PG8_SB(1, 0), b3, voffB); PG8_STAGE(PG8_SB(1, 1), b3 + hstep, voffB); PG8_STAGE(PG8_SA(1, 0), a3, voffA);
            PG8_WAIT_V(8); PG8_WAIT_L(0); PG8_BAR; PG8_MMA(1, 0, At, B0); PG8_MMA(1, 1, At, B1); PG8_BAR; PG8_SCHED;
        }
        if (wr == 0) PG8_BAR;
        E(acc, cur, wr, wc, fr, fq);
        if (!has_next) break;
#pragma unroll
        for (int a = 0; a < 2; ++a)
#pragma unroll
            for (int b = 0; b < 2; ++b)
#pragma unroll
                for (int m = 0; m < 4; ++m)
#pragma unroll
                    for (int n = 0; n < 2; ++n) acc[a][b][m][n] = (f32x4){0.f, 0.f, 0.f, 0.f};
        cur = nxt; cA = nA; cB = nB; ++ui;
        if (wr == 1) PG8_BAR;
    }
    PG8_WAIT_V(0);
    PG8_BAR;
#undef PG8_SA
#undef PG8_SB
#undef PG8_STAGE
#undef PG8_LDA
#undef PG8_LDB
#undef PG8_MMA
#undef PG8_WAIT_V
#undef PG8_WAIT_L
#undef PG8_BAR
#undef PG8_SCHED
}
}
using pg8::Unit;

typedef f32x4 AccT[2][2][4][2];

#define OPAQUE(o) asm volatile("" : "+v"(o))
struct EpiPlain {
    bf16_t* O; int ldc;
    __device__ __forceinline__ void operator()(const AccT& acc, const Unit& u, int wr, int wc, int fr, int fq) const {
        const unsigned lo = (unsigned)((u.pm * 256 + wr * 64 + fr) * ldc + u.pn * 256 + wc * 32 + 8 * fq) * 2u;
#pragma unroll
        for (int ai = 0; ai < 2; ++ai)
#pragma unroll
            for (int m = 0; m < 4; ++m) { unsigned o = lo + (unsigned)((ai * 128 + m * 16) * ldc) * 2u; OPAQUE(o); char* rowp = (char*)O + o;
#pragma unroll
                for (int bj = 0; bj < 2; ++bj) { const f32x4 v0 = acc[ai][bj][m][0], v1 = acc[ai][bj][m][1];
                    u32x4 w; w.x = cvt_pk_bf16(v0[0], v0[1]); w.y = cvt_pk_bf16(v0[2], v0[3]); w.z = cvt_pk_bf16(v1[0], v1[1]); w.w = cvt_pk_bf16(v1[2], v1[3]);
                    *(u32x4*)(rowp + bj * 256) = w; } }
    }
};
struct EpiSwiglu {
    bf16_t* O;
    __device__ __forceinline__ void operator()(const AccT& acc, const Unit& u, int wr, int wc, int fr, int fq) const {
        const unsigned lo = (unsigned)((u.pm * 256 + wr * 64 + fr) * FF + u.pn * 128 + wc * 32 + 8 * fq) * 2u;
#pragma unroll
        for (int ai = 0; ai < 2; ++ai)
#pragma unroll
            for (int m = 0; m < 4; ++m) { unsigned o = lo + (unsigned)((ai * 128 + m * 16) * FF) * 2u; OPAQUE(o); char* rowp = (char*)O + o;
                float r[8];
#pragma unroll
                for (int n = 0; n < 2; ++n)
#pragma unroll
                    for (int j = 0; j < 4; ++j) { const float gt = acc[ai][0][m][n][j], up = acc[ai][1][m][n][j]; r[n * 4 + j] = gt * sigmoidf_(gt) * up; }
                u32x4 w; w.x = cvt_pk_bf16(r[0], r[1]); w.y = cvt_pk_bf16(r[2], r[3]); w.z = cvt_pk_bf16(r[4], r[5]); w.w = cvt_pk_bf16(r[6], r[7]);
                *(u32x4*)rowp = w; }
    }
};
struct EpiProj {
    bf16_t* O; const float* rope; const float* bgate; int posmask;
    __device__ __forceinline__ void operator()(const AccT& acc, const Unit& u, int wr, int wc, int fr, int fq) const {
        const int pn = u.pn;
        const int row0 = u.pm * 256 + wr * 64 + fr, col0 = pn * 256 + wc * 32 + 8 * fq;
        const unsigned lo = (unsigned)(row0 * INW + col0) * 2u;
        const bool ropeTile = pn < 6, gateTile = pn >= 15;
        const float sc = (pn < 3 || pn == 9 || pn == 10) ? QSCALE : 1.0f;
        const bool rot = ropeTile && ((wc & 1) == 0) && (fq < 2);
        if (gateTile) {
#pragma unroll
            for (int bj = 0; bj < 2; ++bj) { const f32x4 b0 = *(const f32x4*)(bgate + col0 - GOFF + bj * 128), b1 = *(const f32x4*)(bgate + col0 - GOFF + bj * 128 + 4);
#pragma unroll
                for (int ai = 0; ai < 2; ++ai)
#pragma unroll
                    for (int m = 0; m < 4; ++m) { unsigned o = lo + (unsigned)((ai * 128 + m * 16) * INW) * 2u + bj * 256; OPAQUE(o);
                        f32x4 v0 = acc[ai][bj][m][0] + b0, v1 = acc[ai][bj][m][1] + b1;
#pragma unroll
                        for (int j = 0; j < 4; ++j) { v0[j] = sigmoidf_(v0[j]); v1[j] = sigmoidf_(v1[j]); }
                        u32x4 w; w.x = cvt_pk_bf16(v0[0], v0[1]); w.y = cvt_pk_bf16(v0[2], v0[3]); w.z = cvt_pk_bf16(v1[0], v1[1]); w.w = cvt_pk_bf16(v1[2], v1[3]);
                        *(u32x4*)((char*)O + o) = w; } }
        } else {
#pragma unroll
            for (int ai = 0; ai < 2; ++ai)
#pragma unroll
                for (int m = 0; m < 4; ++m) { unsigned o = lo + (unsigned)((ai * 128 + m * 16) * INW) * 2u; OPAQUE(o);
                    f32x4 cs = (f32x4){1.f, 1.f, 1.f, 1.f}, sn = (f32x4){0.f, 0.f, 0.f, 0.f};
                    if (rot) { unsigned ro = (unsigned)(((row0 + ai * 128 + m * 16) & posmask) * 16 + 4 * fq) * 4u; OPAQUE(ro); cs = *(const f32x4*)((const char*)rope + ro); sn = *(const f32x4*)((const char*)rope + ro + 32); }
#pragma unroll
                    for (int bj = 0; bj < 2; ++bj) { f32x4 v0 = acc[ai][bj][m][0], v1 = acc[ai][bj][m][1];
                        if (ropeTile) { const f32x4 x1 = v0, x2 = v1; v0 = x1 * cs - x2 * sn; v1 = x2 * cs + x1 * sn; }
                        v0 = v0 * sc; v1 = v1 * sc;
                        u32x4 w; w.x = cvt_pk_bf16(v0[0], v0[1]); w.y = cvt_pk_bf16(v0[2], v0[3]); w.z = cvt_pk_bf16(v1[0], v1[1]); w.w = cvt_pk_bf16(v1[2], v1[3]);
                        *(u32x4*)((char*)O + o + bj * 256) = w; }
                    asm volatile("" ::: "memory"); }
        }
    }
};
template <bool ADD> struct EpiGate {
    bf16_t* Z; const bf16_t* P; int goff;
    __device__ __forceinline__ void operator()(const AccT& acc, const Unit& u, int wr, int wc, int fr, int fq) const {
        const int row0 = u.pm * 256 + wr * 64 + fr, col0 = u.pn * 256 + wc * 32 + 8 * fq;
        const unsigned zl = (unsigned)(row0 * DM + col0) * 2u, gl = (unsigned)(row0 * INW + goff + col0) * 2u;
#pragma unroll
        for (int ai = 0; ai < 2; ++ai)
#pragma unroll
            for (int m = 0; m < 4; ++m) {
                unsigned zo_ = zl + (unsigned)((ai * 128 + m * 16) * DM) * 2u, go_ = gl + (unsigned)((ai * 128 + m * 16) * INW) * 2u; OPAQUE(zo_); OPAQUE(go_);
                char* zp = (char*)Z + zo_; const char* gp = (const char*)P + go_;
#pragma unroll
                for (int bj = 0; bj < 2; ++bj) { const f32x4 v0 = acc[ai][bj][m][0], v1 = acc[ai][bj][m][1];
                    const u32x4 gw = *(const u32x4*)(gp + bj * 256);
                    float r[8];
                    r[0] = bf_lo(gw.x) * v0[0]; r[1] = bf_hi(gw.x) * v0[1]; r[2] = bf_lo(gw.y) * v0[2]; r[3] = bf_hi(gw.y) * v0[3];
                    r[4] = bf_lo(gw.z) * v1[0]; r[5] = bf_hi(gw.z) * v1[1]; r[6] = bf_lo(gw.w) * v1[2]; r[7] = bf_hi(gw.w) * v1[3];
                    if (ADD) { const u32x4 zo = *(const u32x4*)(zp + bj * 256);
                        r[0] += bf_lo(zo.x); r[1] += bf_hi(zo.x); r[2] += bf_lo(zo.y); r[3] += bf_hi(zo.y); r[4] += bf_lo(zo.z); r[5] += bf_hi(zo.z); r[6] += bf_lo(zo.w); r[7] += bf_hi(zo.w); }
                    u32x4 w; w.x = cvt_pk_bf16(r[0], r[1]); w.y = cvt_pk_bf16(r[2], r[3]); w.z = cvt_pk_bf16(r[4], r[5]); w.w = cvt_pk_bf16(r[6], r[7]);
                    *(u32x4*)(zp + bj * 256) = w; }
                asm volatile("" ::: "memory"); }
    }
};

struct Args {
    const float* in[20];
    float* out;
    unsigned char* ws;
};

__device__ __forceinline__ void transpose_item(const float* W, int ldw, int sc, bf16_t* WT, int K, int n0, int k0, LAS float* scr, int lane) {
#pragma unroll 8
    for (int i = 0; i < 32; ++i) { const int kk = 2 * i + (lane >> 5); scr[kk * 33 + (lane & 31)] = W[(size_t)(k0 + kk) * ldw + sc]; }
    asm volatile("s_waitcnt lgkmcnt(0)" ::: "memory");
    const int c = lane & 7;
#pragma unroll
    for (int j = 0; j < 4; ++j) { const int n = (lane >> 3) + 8 * j; const LAS float* s = scr + (8 * c) * 33 + n;
        u32x4 o; o.x = cvt_pk_bf16(s[0 * 33], s[1 * 33]); o.y = cvt_pk_bf16(s[2 * 33], s[3 * 33]); o.z = cvt_pk_bf16(s[4 * 33], s[5 * 33]); o.w = cvt_pk_bf16(s[6 * 33], s[7 * 33]);
        *(u32x4*)(WT + (size_t)(n0 + n) * K + k0 + 8 * c) = o; }
    asm volatile("s_waitcnt lgkmcnt(0)" ::: "memory");
}
template <int KIND>
__device__ __forceinline__ void transpose_items(const float* W0, const float* W1, int ldw, bf16_t* WT, int K, int N, LAS float* scr, int lane, int gw, int NGW) {
    const int nblk = N / 32, nitems = (K / 64) * nblk;
    for (int it = gw; it < nitems; it += NGW) {
        const int kb = it / nblk, nb = it % nblk, n0 = nb * 32, n = n0 + (lane & 31);
        const float* W = W0; int sc = n;
        if (KIND == 1) { const int tile = n >> 8, bj = (n >> 7) & 1, j = n & 127; W = bj ? W1 : W0; sc = tile * 128 + j; }
        if (KIND == 2) { if (n < 1536 && (n & 63) < 16) { const int p = n & 15; const int d = (p < 8) ? ((p & 3) + ((p >> 2) << 3)) : (4 + (p & 3) + (((p - 8) >> 2) << 3)); sc = (n & ~15) + d; } }
        transpose_item(W, ldw, sc, WT, K, n0, kb * 64, scr, lane);
    }
}

template <bool HAS_D, bool HAS_H, bool XIN16, bool XOUT16>
__device__ __forceinline__ void row_pass(const float* xa, const float* xb, const bf16_t* x16in, const bf16_t* D, const float* gpost, float dscale, float* xout, bf16_t* x16out, const float* gpre, bf16_t* hout, int lane, int gw, int NGW) {
    f32x4 gp[4], gq[4];
#pragma unroll
    for (int j = 0; j < 4; ++j) { if (HAS_D) gp[j] = *(const f32x4*)(gpost + 4 * lane + 256 * j); if (HAS_H) gq[j] = *(const f32x4*)(gpre + 4 * lane + 256 * j); }
    for (int row = gw; row < TALL; row += NGW) {
        f32x4 v[4];
        if (XIN16) {
#pragma unroll
            for (int j = 0; j < 4; ++j) { const u32x2 w = *(const u32x2*)(x16in + (size_t)row * DM + 4 * lane + 256 * j); v[j] = (f32x4){bf_lo(w.x), bf_hi(w.x), bf_lo(w.y), bf_hi(w.y)}; }
        } else {
            const float* xr = (row < TP) ? xa + (size_t)row * DM : xb + (size_t)(row - TP) * DM;
#pragma unroll
            for (int j = 0; j < 4; ++j) v[j] = *(const f32x4*)(xr + 4 * lane + 256 * j);
        }
        if (HAS_D) {
            f32x4 d[4]; float ss = 0.f;
#pragma unroll
            for (int j = 0; j < 4; ++j) { const u32x2 w = *(const u32x2*)(D + (size_t)row * DM + 4 * lane + 256 * j);
                d[j] = (f32x4){bf_lo(w.x), bf_hi(w.x), bf_lo(w.y), bf_hi(w.y)}; ss += (d[j][0] * d[j][0] + d[j][1] * d[j][1]) + (d[j][2] * d[j][2] + d[j][3] * d[j][3]); }
            const float r = dscale * __builtin_amdgcn_rsqf(wave_sum(ss) * (1.0f / DM) + RMS_EPS);
#pragma unroll
            for (int j = 0; j < 4; ++j) { v[j] = v[j] + d[j] * gp[j] * r;
                if (XOUT16) { u32x2 w; w.x = cvt_pk_bf16(v[j][0], v[j][1]); w.y = cvt_pk_bf16(v[j][2], v[j][3]); *(u32x2*)(x16out + (size_t)row * DM + 4 * lane + 256 * j) = w; }
                else *(f32x4*)(xout + (size_t)row * DM + 4 * lane + 256 * j) = v[j]; }
        }
        if (HAS_H) {
            float ss = 0.f;
#pragma unroll
            for (int j = 0; j < 4; ++j) ss += (v[j][0] * v[j][0] + v[j][1] * v[j][1]) + (v[j][2] * v[j][2] + v[j][3] * v[j][3]);
            const float r = __builtin_amdgcn_rsqf(wave_sum(ss) * (1.0f / DM) + RMS_EPS);
#pragma unroll
            for (int j = 0; j < 4; ++j) { const f32x4 o = v[j] * gq[j] * r; u32x2 w; w.x = cvt_pk_bf16(o[0], o[1]); w.y = cvt_pk_bf16(o[2], o[3]);
                *(u32x2*)(hout + (size_t)row * DM + 4 * lane + 256 * j) = w; }
        }
    }
}

constexpr int KS = 144;
constexpr int WAVE_LDS = 2 * 32 * KS;
constexpr int RPB_OFF = 81920;
__device__ __forceinline__ int crow(int r, int hi) { return (r & 3) + 8 * (r >> 2) + 4 * hi; }
__device__ __forceinline__ s16x4 vtr(LAS const unsigned char* p) { return __builtin_bit_cast(s16x4, __builtin_amdgcn_ds_read_tr16_b64_v4i16((LAS s16x4*)p)); }

struct KVRegs { u32x4 k[4], v[4]; };

#define ATT_LOAD(R, tokexpr) do { _Pragma("unroll") for (int _i = 0; _i < 4; ++_i) { const int _rowi = (lane >> 3) + 8 * _i; const size_t _tok = (size_t)(tokexpr); \
        const bf16_t* _p = proj + _tok * INW + 8 * (lane & 7); R.k[_i] = *(const u32x4*)(_p + kcol); R.v[_i] = *(const u32x4*)(_p + vcol); } } while (0)
#define ATT_STORE(R) do { _Pragma("unroll") for (int _i = 0; _i < 4; ++_i) { const int _rowi = (lane >> 3) + 8 * _i; \
        *(LAS u32x4*)(wl + _rowi * KS + 16 * (lane & 7)) = R.k[_i]; *(LAS u32x4*)(wl + 32 * KS + _rowi * KS + 16 * (lane & 7)) = R.v[_i]; } } while (0)
#define ATT_QK(s) do { s = (f32x16){0.f,0.f,0.f,0.f,0.f,0.f,0.f,0.f,0.f,0.f,0.f,0.f,0.f,0.f,0.f,0.f}; _Pragma("unroll") for (int _d = 0; _d < 4; ++_d) { \
        const bf16x8 _kf = *(const LAS bf16x8*)(wl + q32 * KS + 32 * _d + 16 * hi); s = __builtin_amdgcn_mfma_f32_32x32x16_bf16(_kf, qr[_d], s, 0, 0, 0); } } while (0)
#define ATT_SOFTMAX_PV(s) do { \
        float _tm = s[0]; _Pragma("unroll") for (int _r = 1; _r < 16; ++_r) _tm = fmaxf(_tm, s[_r]); \
        _tm = fmaxf(_tm, __shfl_xor(_tm, 32)); \
        if (__any(_tm > m_run)) { const float _mn = fmaxf(m_run, _tm), _al = fexp2(m_run - _mn); m_run = _mn; l_run *= _al; \
            _Pragma("unroll") for (int _r = 0; _r < 16; ++_r) { oT0[_r] *= _al; oT1[_r] *= _al; } } \
        float _sum = 0.f; _Pragma("unroll") for (int _r = 0; _r < 16; ++_r) { s[_r] = fexp2(s[_r] - m_run); _sum += s[_r]; } \
        l_run += _sum; \
        u32x4 _p0, _p1; _p0.x = cvt_pk_bf16(s[0], s[1]); _p0.y = cvt_pk_bf16(s[2], s[3]); _p0.z = cvt_pk_bf16(s[4], s[5]); _p0.w = cvt_pk_bf16(s[6], s[7]); \
        _p1.x = cvt_pk_bf16(s[8], s[9]); _p1.y = cvt_pk_bf16(s[10], s[11]); _p1.z = cvt_pk_bf16(s[12], s[13]); _p1.w = cvt_pk_bf16(s[14], s[15]); \
        const bf16x8 _pb0 = __builtin_bit_cast(bf16x8, _p0), _pb1 = __builtin_bit_cast(bf16x8, _p1); \
        { const s16x4 a = vtr(vtb), b = vtr(vtb + 8 * KS); const bf16x8 vf = (bf16x8){a[0], a[1], a[2], a[3], b[0], b[1], b[2], b[3]}; oT0 = __builtin_amdgcn_mfma_f32_32x32x16_bf16(vf, _pb0, oT0, 0, 0, 0); } \
        { const s16x4 a = vtr(vtb + 16 * KS), b = vtr(vtb + 24 * KS); const bf16x8 vf = (bf16x8){a[0], a[1], a[2], a[3], b[0], b[1], b[2], b[3]}; oT0 = __builtin_amdgcn_mfma_f32_32x32x16_bf16(vf, _pb1, oT0, 0, 0, 0); } \
        { const s16x4 a = vtr(vtb + 64), b = vtr(vtb + 64 + 8 * KS); const bf16x8 vf = (bf16x8){a[0], a[1], a[2], a[3], b[0], b[1], b[2], b[3]}; oT1 = __builtin_amdgcn_mfma_f32_32x32x16_bf16(vf, _pb0, oT1, 0, 0, 0); } \
        { const s16x4 a = vtr(vtb + 64 + 16 * KS), b = vtr(vtb + 64 + 24 * KS); const bf16x8 vf = (bf16x8){a[0], a[1], a[2], a[3], b[0], b[1], b[2], b[3]}; oT1 = __builtin_amdgcn_mfma_f32_32x32x16_bf16(vf, _pb1, oT1, 0, 0, 0); } \
    } while (0)
#define ATT_WRITE_O(orow) do { \
        _Pragma("unroll") for (int _g = 0; _g < 4; ++_g) { \
            u32x2 w0, w1; w0.x = cvt_pk_bf16(oT0[4 * _g] * inv, oT0[4 * _g + 1] * inv); w0.y = cvt_pk_bf16(oT0[4 * _g + 2] * inv, oT0[4 * _g + 3] * inv); \
            w1.x = cvt_pk_bf16(oT1[4 * _g] * inv, oT1[4 * _g + 1] * inv); w1.y = cvt_pk_bf16(oT1[4 * _g + 2] * inv, oT1[4 * _g + 3] * inv); \
            *(u32x2*)((orow) + 8 * _g + 4 * hi) = w0; *(u32x2*)((orow) + 32 + 8 * _g + 4 * hi) = w1; } } while (0)

__device__ __forceinline__ void attnA_unit(int u, const bf16_t* proj, bf16_t* og, float* lse, int S, LAS unsigned char* wl, int lane) {
    const int q32 = lane & 31, hi = lane >> 5;
    const int g = u / 2048, rem = u % 2048, h = rem / 512, idx = rem % 512;
    const int per_seq = S / 32, seq = idx / per_seq, ii = idx % per_seq;
    const int dsh = 2 * g, dl = 1 << dsh;
    const int r = ii & (dl - 1), c = ii >> dsh, L = S >> dsh;
    const int hd = 4 * g + h, qcol = hd * 64, kcol = 768 + hd * 64, vcol = 1536 + hd * 64;
    const size_t seqbase = (size_t)seq * S;
    const int qm = 32 * c + q32;
    const size_t qtok = seqbase + (size_t)qm * dl + r;
    bf16x8 qr[4];
#pragma unroll
    for (int d = 0; d < 4; ++d) qr[d] = *(const bf16x8*)(proj + qtok * INW + qcol + 16 * d + 8 * hi);
    const int m0 = 32 * c - 64;
    LAS const unsigned char* vtb = wl + 32 * KS + (4 * hi + ((lane & 15) >> 2)) * KS + (16 * ((lane >> 4) & 1) + 4 * (lane & 3)) * 2;
    float m_run = -1e29f, l_run = 0.f;
    f32x16 oT0 = (f32x16){0.f,0.f,0.f,0.f,0.f,0.f,0.f,0.f,0.f,0.f,0.f,0.f,0.f,0.f,0.f,0.f}, oT1 = oT0;
    KVRegs Ra, Rb;
#define TOKA(t) (seqbase + (size_t)min(max(m0 + 32 * (t) + _rowi, 0), L - 1) * dl + r)
#define A_TILE(t) do { \
        f32x16 s; ATT_QK(s); \
        const int kb0 = m0 + 32 * (t); \
        if (kb0 < 0 || kb0 + 32 > L) { \
            _Pragma("unroll") for (int rr = 0; rr < 16; ++rr) { const int km = kb0 + crow(rr, hi); const int dk = km - qm; \
                const bool ok = (km >= 0) && (km < L) && (dk <= 64) && (dk >= -64); s[rr] = ok ? s[rr] : NEGBIG; } \
        } else if ((t) == 0) { \
            _Pragma("unroll") for (int rr = 0; rr < 16; ++rr) s[rr] = (crow(rr, hi) >= q32) ? s[rr] : NEGBIG; \
        } else if ((t) == 4) { \
            _Pragma("unroll") for (int rr = 0; rr < 16; ++rr) s[rr] = (crow(rr, hi) <= q32) ? s[rr] : NEGBIG; \
        } \
        ATT_SOFTMAX_PV(s); } while (0)
    ATT_LOAD(Ra, TOKA(0)); ATT_LOAD(Rb, TOKA(1));
    ATT_STORE(Ra); ATT_LOAD(Ra, TOKA(2)); A_TILE(0);
    ATT_STORE(Rb); ATT_LOAD(Rb, TOKA(3)); A_TILE(1);
    ATT_STORE(Ra); ATT_LOAD(Ra, TOKA(4)); A_TILE(2);
    ATT_STORE(Rb); A_TILE(3);
    ATT_STORE(Ra); A_TILE(4);
#undef A_TILE
#undef TOKA
    const float lt = l_run + __shfl_xor(l_run, 32);
    const float inv = frcp(lt);
    bf16_t* orow = og + qtok * 768 + hd * 64;
    ATT_WRITE_O(orow);
    if (hi == 0) lse[qtok * 12 + hd] = m_run + __builtin_amdgcn_logf(lt);
}

__device__ __forceinline__ void attnB_unit(int u, const bf16_t* proj, bf16_t* ob, int S, LAS unsigned char* wl, LAS const float* rpbL, int lane) {
    const int q32 = lane & 31, hi = lane >> 5;
    const int h = u / 512, idx = u % 512;
    const int per_seq = S / 32, seq = idx / per_seq, ii = idx % per_seq;
    const int rp = ii >> 2, cc = ii & 3, rows = S / 64;
    const int ri0 = 2 * rp, qrow = ri0 + (q32 >> 4), qcolg = 16 * cc + (q32 & 15);
    const int qcol = 2304 + h * 64, kcol = 2816 + h * 64, vcol = 3328 + h * 64;
    const size_t seqbase = (size_t)seq * S;
    const size_t qtok = seqbase + (size_t)qrow * 64 + qcolg;
    bf16x8 qr[4];
#pragma unroll
    for (int d = 0; d < 4; ++d) qr[d] = *(const bf16x8*)(proj + qtok * INW + qcol + 16 * d + 8 * hi);
    const int w0 = (cc == 0) ? 0 : (cc == 1) ? 8 : (cc == 2) ? 24 : 32;
    const int rs0 = min(max(ri0 - 4, 0), rows - 8), rs1 = min(max(ri0 - 3, 0), rows - 8);
    const int ntile = rs1 + 8 - rs0;
    const int rsq = min(max(qrow - 4, 0), rows - 8), csq = min(max(qcolg - 8, 0), 48);
    LAS const unsigned char* vtb = wl + 32 * KS + (4 * hi + ((lane & 15) >> 2)) * KS + (16 * ((lane >> 4) & 1) + 4 * (lane & 3)) * 2;
    LAS const float* rb = rpbL + h * 465;
    const unsigned vmaskh = (0xFFFFu << (csq - w0)) >> (4 * hi);
    float m_run = -1e29f, l_run = 0.f;
    f32x16 oT0 = (f32x16){0.f,0.f,0.f,0.f,0.f,0.f,0.f,0.f,0.f,0.f,0.f,0.f,0.f,0.f,0.f,0.f}, oT1 = oT0;
    KVRegs Ra, Rb;
#define TOKB(t) (seqbase + (size_t)(rs0 + (t)) * 64 + w0 + _rowi)
#define B_TILE(t) do { \
        f32x16 s; ATT_QK(s); \
        const int kr = rs0 + (t); \
        const bool rowok = (kr >= rsq) && (kr < rsq + 8); \
        LAS const float* rbt = rb + ((kr - qrow + 7) * 31 + (w0 - qcolg + 15) + 4 * hi); \
        const unsigned mh = rowok ? vmaskh : 0u; \
        float bv[16]; \
        _Pragma("unroll") for (int rr = 0; rr < 16; ++rr) bv[rr] = rbt[(rr & 3) + 8 * (rr >> 2)];     \
        _Pragma("unroll") for (int rr = 0; rr < 16; ++rr) { const int ko = (rr & 3) + 8 * (rr >> 2); \
            const float sb = s[rr] + bv[rr]; s[rr] = (mh & (1u << ko)) ? sb : NEGBIG; } \
        ATT_SOFTMAX_PV(s); } while (0)
    ATT_LOAD(Ra, TOKB(0)); ATT_LOAD(Rb, TOKB(1));
    ATT_STORE(Ra); ATT_LOAD(Ra, TOKB(2)); B_TILE(0);
    ATT_STORE(Rb); ATT_LOAD(Rb, TOKB(3)); B_TILE(1);
    ATT_STORE(Ra); ATT_LOAD(Ra, TOKB(4)); B_TILE(2);
    ATT_STORE(Rb); ATT_LOAD(Rb, TOKB(5)); B_TILE(3);
    ATT_STORE(Ra); ATT_LOAD(Ra, TOKB(6)); B_TILE(4);
    ATT_STORE(Rb); ATT_LOAD(Rb, TOKB(7)); B_TILE(5);
    ATT_STORE(Ra); if (ntile > 8) { ATT_LOAD(Ra, TOKB(8)); } B_TILE(6);
    ATT_STORE(Rb); B_TILE(7);
    if (ntile > 8) { ATT_STORE(Ra); B_TILE(8); }
#undef B_TILE
#undef TOKB
    const float lt = l_run + __shfl_xor(l_run, 32);
    const float inv = frcp(lt);
    bf16_t* orow = ob + qtok * 512 + h * 64;
    ATT_WRITE_O(orow);
}


#define XB_TMO      128
#define XB_XCNT(j)  (256  + 64 * (j))
#define XB_XSUB(j)  (1280 + 64 * (j))
#define XB_XGEN(j)  (2304 + 64 * (j))
#define XB_TOP      3328
#define XB_TOPGEN   3392
#define XCD_BAR_WORDS 3456
#define XB_SPIN_CAP (1u << 18)
__device__ __forceinline__ unsigned xb_ld(unsigned* p)              { return __hip_atomic_load(p, __ATOMIC_RELAXED, __HIP_MEMORY_SCOPE_AGENT); }
__device__ __forceinline__ unsigned xb_add(unsigned* p, unsigned v) { return __hip_atomic_fetch_add(p, v, __ATOMIC_RELAXED, __HIP_MEMORY_SCOPE_AGENT); }
__device__ __forceinline__ unsigned xb_xcc_id() { return (unsigned)__builtin_amdgcn_s_getreg((3 << 11) | 20) & 0xFu; }
#define XB_SPIN(cond, bar) do { unsigned _sp = 0; while (cond) { __builtin_amdgcn_s_sleep(1); \
    if ((++_sp & 255u) == 0u) { if (xb_ld(&(bar)[XB_TMO])) break; if (_sp > XB_SPIN_CAP) { atomicAdd(&(bar)[XB_TMO], 1u); break; } } } } while (0)
struct XcdBarrier { unsigned* bar; unsigned x; volatile LAS unsigned* st; };
__device__ __forceinline__ XcdBarrier xcd_barrier_post(unsigned* bar, volatile LAS unsigned* st) {
    XcdBarrier b; b.bar = bar; b.x = xb_xcc_id(); b.st = st;
    if (threadIdx.x == 0) (void)xb_add(&bar[XB_XCNT(b.x)], 1u);
    return b;
}
__device__ __forceinline__ void xcd_barrier_complete(unsigned* bar, unsigned x, unsigned& nloc, unsigned& nx) {
    const unsigned G = gridDim.x * gridDim.y * gridDim.z;
    unsigned sum, cnt, mine, sp = 0u;
    for (;;) {
        sum = 0u; cnt = 0u; mine = 0u;
#pragma unroll
        for (unsigned j = 0; j < 16; ++j) { const unsigned c = xb_ld(&bar[XB_XCNT(j)]); sum += c; cnt += (c > 0u) ? 1u : 0u; mine = (j == x) ? c : mine; }
        if (sum == G) break;
        __builtin_amdgcn_s_sleep(1);
        if ((++sp & 255u) == 0u) { if (xb_ld(&bar[XB_TMO])) break; if (sp > XB_SPIN_CAP) { atomicAdd(&bar[XB_TMO], 1u); break; } }
    }
    nloc = mine > 0u ? mine : 1u; nx = cnt > 0u ? cnt : 1u;
}
__device__ __forceinline__ void xcd_barrier(const XcdBarrier& b) {
    asm volatile("s_waitcnt vmcnt(0)" ::: "memory");
    __syncthreads();
    if (threadIdx.x == 0) {
        unsigned* bar = b.bar;
        __builtin_amdgcn_s_waitcnt(0);
        unsigned nloc = b.st[0], nx = b.st[1];
        if (nloc == 0u) { xcd_barrier_complete(bar, b.x, nloc, nx); b.st[0] = nloc; b.st[1] = nx; }
        const unsigned old = xb_add(&bar[XB_XSUB(b.x)], 1u);
        const unsigned gen = old / nloc;
        if (old + 1u == (gen + 1u) * nloc) {
            __builtin_amdgcn_fence(__ATOMIC_RELEASE, "agent");
            asm volatile("s_waitcnt vmcnt(0)" ::: "memory");
            const unsigned og = xb_add(&bar[XB_TOP], 1u);
            const unsigned tg = og / nx;
            if (og + 1u == (tg + 1u) * nx) xb_add(&bar[XB_TOPGEN], 1u);
            else XB_SPIN(xb_ld(&bar[XB_TOPGEN]) == tg, bar);
            __builtin_amdgcn_fence(__ATOMIC_ACQUIRE, "agent");
            xb_add(&bar[XB_XGEN(b.x)], 1u);
            asm volatile("s_waitcnt vmcnt(0)" ::: "memory");
        } else {
            XB_SPIN(xb_ld(&bar[XB_XGEN(b.x)]) == gen, bar);
            __builtin_amdgcn_fence(__ATOMIC_ACQUIRE, "agent");
            asm volatile("s_waitcnt vmcnt(0)" ::: "memory");
        }
    }
    __syncthreads();
}

#define CGSYNC() do { asm volatile("s_waitcnt vmcnt(0) lgkmcnt(0)" ::: "memory"); grid.sync(); __builtin_amdgcn_fence(__ATOMIC_ACQUIRE, "agent"); asm volatile("s_waitcnt vmcnt(0)" ::: "memory"); } while (0)
#define GSYNC() xcd_barrier(xbar)

template <int CH>
__device__ __forceinline__ void mixer_chunk(const XcdBarrier& xbar, LAS unsigned char* lds, int G, int gw, int NGW, const bf16_t* H, const bf16_t* Win, const bf16_t* Wa, const bf16_t* Wb, const bf16_t* Wout,
        bf16_t* proj, bf16_t* og, float* lse, bf16_t* oa, bf16_t* ob, bf16_t* Z, bf16_t* Dbuf, const float* rope, const float* bgate, const float* rpb) {
    int tid_ = threadIdx.x; asm volatile("" : "+v"(tid_));
    const int tid = tid_, lane = tid & 63, wid = __builtin_amdgcn_readfirstlane(tid >> 6);
    pg8::StaticOrder SO;
    const int gwx = ((G % 8 == 0) ? ((int)(blockIdx.x % 8) * (G / 8) + (int)(blockIdx.x / 8)) : (int)blockIdx.x) * NWAVES + wid;

        constexpr int ch = CH; constexpr int S = (CH == 0) ? 8192 : 16384;
        const bf16_t* Hc = H + (size_t)ch * TC * DM;
        { pg8::Gemm g{Hc, Win, TC, INW, DM}; SO.init(TC, INW, G, blockIdx.x); EpiProj E{proj, rope, bgate, S - 1}; pg8::gemm_phase(lds, g, SO, E); }
        GSYNC();
        {
            LAS unsigned char* wl = lds + wid * WAVE_LDS;
            for (int u = gwx; u < 3 * 4 * (TC / 32); u += NGW) { if (!SKIP_A) attnA_unit(u, proj, og, lse, S, wl, lane); }
        }
        GSYNC();
        {
            LAS float* rpbL = (LAS float*)(lds + RPB_OFF);
            for (int i = tid; i < 8 * 465; i += NTHR) rpbL[i] = rpb[i] * LOG2E;
            __syncthreads();
            LAS unsigned char* wl = lds + wid * WAVE_LDS;
            for (int u = gwx; u < 8 * (TC / 32); u += NGW) { if (!SKIP_B) attnB_unit(u, proj, ob, S, wl, rpbL, lane); }
            for (int i = blockIdx.x * NTHR + tid; i < TC * 32; i += G * NTHR) {
                const int tl = i >> 5, h = (i >> 3) & 3, c8 = i & 7;
                const float l0 = lse[tl * 12 + h], l1 = lse[tl * 12 + 4 + h], l2 = lse[tl * 12 + 8 + h];
                const float mx = fmaxf(l0, fmaxf(l1, l2));
                float e0 = fexp2(l0 - mx), e1 = fexp2(l1 - mx), e2 = fexp2(l2 - mx);
                const float is = frcp(e0 + e1 + e2); e0 *= is; e1 *= is; e2 *= is;
                const bf16_t* p = og + (size_t)tl * 768 + h * 64 + c8 * 8;
                const u32x4 v0 = *(const u32x4*)p, v1 = *(const u32x4*)(p + 256), v2 = *(const u32x4*)(p + 512);
                u32x4 w;
                w.x = cvt_pk_bf16(e0 * bf_lo(v0.x) + e1 * bf_lo(v1.x) + e2 * bf_lo(v2.x), e0 * bf_hi(v0.x) + e1 * bf_hi(v1.x) + e2 * bf_hi(v2.x));
                w.y = cvt_pk_bf16(e0 * bf_lo(v0.y) + e1 * bf_lo(v1.y) + e2 * bf_lo(v2.y), e0 * bf_hi(v0.y) + e1 * bf_hi(v1.y) + e2 * bf_hi(v2.y));
                w.z = cvt_pk_bf16(e0 * bf_lo(v0.z) + e1 * bf_lo(v1.z) + e2 * bf_lo(v2.z), e0 * bf_hi(v0.z) + e1 * bf_hi(v1.z) + e2 * bf_hi(v2.z));
                w.w = cvt_pk_bf16(e0 * bf_lo(v0.w) + e1 * bf_lo(v1.w) + e2 * bf_lo(v2.w), e0 * bf_hi(v0.w) + e1 * bf_hi(v1.w) + e2 * bf_hi(v2.w));
                *(u32x4*)(oa + (size_t)tl * 256 + h * 64 + c8 * 8) = w;
            }
        }
        GSYNC();
        { pg8::Gemm g{oa, Wa, TC, DM, 256}; SO.init(TC, DM, G, blockIdx.x); EpiGate<false> E{Z, proj, GOFF}; pg8::gemm_phase(lds, g, SO, E); }
        { pg8::Gemm g{ob, Wb, TC, DM, 512}; SO.init(TC, DM, G, blockIdx.x); EpiGate<true> E{Z, proj, GOFF + DM}; pg8::gemm_phase(lds, g, SO, E); }
        GSYNC();
        { pg8::Gemm g{Z, Wout, TC, DM, DM}; SO.init(TC, DM, G, blockIdx.x); EpiPlain E{Dbuf + (size_t)ch * TC * DM, DM}; pg8::gemm_phase(lds, g, SO, E); }

}

__global__ void __launch_bounds__(NTHR, 2) enc_fwd(Args a) {
    extern __shared__ __attribute__((aligned(16))) unsigned char lds_raw[];
    LAS unsigned char* lds = (LAS unsigned char*)lds_raw;
    cg::grid_group grid = cg::this_grid();
    const int tid = threadIdx.x, lane = tid & 63, wid = __builtin_amdgcn_readfirstlane(tid >> 6);
    const int G = gridDim.x, gw = blockIdx.x * NWAVES + wid, NGW = G * NWAVES;
    unsigned char* ws = a.ws;
    const float* x_p = a.in[0]; const float* x_s = a.in[1];
    bf16_t* Wgu1 = (bf16_t*)(ws + WS_WGU1); bf16_t* Wd1 = (bf16_t*)(ws + WS_WD1); bf16_t* Win = (bf16_t*)(ws + WS_WIN);
    bf16_t* Wa = (bf16_t*)(ws + WS_WA); bf16_t* Wb = (bf16_t*)(ws + WS_WB); bf16_t* Wout = (bf16_t*)(ws + WS_WOUT);
    bf16_t* Wgu2 = (bf16_t*)(ws + WS_WGU2); bf16_t* Wd2 = (bf16_t*)(ws + WS_WD2);
    float* rope = (float*)(ws + WS_ROPE); float* lse = (float*)(ws + WS_LSE);
    bf16_t* H = (bf16_t*)(ws + WS_H); bf16_t* A1 = (bf16_t*)(ws + WS_A1); bf16_t* Dbuf = (bf16_t*)(ws + WS_D); bf16_t* XB = (bf16_t*)(ws + WS_XB);
    bf16_t* proj = (bf16_t*)(ws + WS_PROJ); bf16_t* og = (bf16_t*)(ws + WS_OG); bf16_t* oa = (bf16_t*)(ws + WS_OA); bf16_t* ob = (bf16_t*)(ws + WS_OB); bf16_t* Z = (bf16_t*)(ws + WS_Z);
    float* out = a.out;
    volatile LAS unsigned* xst = (volatile LAS unsigned*)(lds + 131072 + 8192);
    if (tid < 2) xst[tid] = 0u;
    __syncthreads();
    const XcdBarrier xbar = xcd_barrier_post((unsigned*)(ws + WS_BAR), xst);

    {
        LAS float* scr = (LAS float*)(lds + wid * 16384);
        transpose_items<1>(a.in[4], a.in[5], FF, Wgu1, DM, 2 * FF, scr, lane, gw, NGW);
        transpose_items<0>(a.in[6], nullptr, DM, Wd1, FF, DM, scr, lane, gw, NGW);
        transpose_items<2>(a.in[9], nullptr, INW, Win, DM, INW, scr, lane, gw, NGW);
        transpose_items<0>(a.in[12], nullptr, DM, Wa, 256, DM, scr, lane, gw, NGW);
        transpose_items<0>(a.in[13], nullptr, DM, Wb, 512, DM, scr, lane, gw, NGW);
        transpose_items<0>(a.in[14], nullptr, DM, Wout, DM, DM, scr, lane, gw, NGW);
        transpose_items<1>(a.in[17], a.in[18], FF, Wgu2, DM, 2 * FF, scr, lane, gw, NGW);
        transpose_items<0>(a.in[19], nullptr, DM, Wd2, FF, DM, scr, lane, gw, NGW);
        for (int i = blockIdx.x * NTHR + tid; i < 16384 * 8; i += G * NTHR) {
            const int pos = i >> 3, f = i & 7;
            const double invf = (f == 0) ? 1.0 : (f == 1) ? 0.19392274474868576 : (f == 2) ? 0.03760603093086393 : (f == 3) ? 0.007292664737217109 : (f == 4) ? 0.001414213562373095
                              : (f == 5) ? 0.0002742481756762073 : (f == 6) ? 5.318295896944988e-05 : 1.031338537721246e-05;
            const float angf = (float)pos * (float)invf;
            double tt = (double)angf * 0.15915494309189535; tt -= floor(tt);
            const float fr = (float)tt;
            rope[pos * 16 + f] = __builtin_amdgcn_cosf(fr); rope[pos * 16 + 8 + f] = __builtin_amdgcn_sinf(fr);
        }
        row_pass<false, true, false, false>(x_p, x_s, nullptr, nullptr, nullptr, 0.f, nullptr, nullptr, a.in[2], H, lane, gw, NGW);
    }
    CGSYNC();
    pg8::StaticOrder SO;
    { pg8::Gemm g{H, Wgu1, TALL, 2 * FF, DM}; SO.init(TALL, 2 * FF, G, blockIdx.x); EpiSwiglu E{A1}; pg8::gemm_phase(lds, g, SO, E); }
    GSYNC();
    { pg8::Gemm g{A1, Wd1, TALL, DM, FF}; SO.init(TALL, DM, G, blockIdx.x); EpiPlain E{Dbuf, DM}; pg8::gemm_phase(lds, g, SO, E); }
    GSYNC();
    row_pass<true, true, false, true>(x_p, x_s, nullptr, Dbuf, a.in[3], 0.5f, nullptr, XB, a.in[7], H, lane, gw, NGW);
    GSYNC();
    if (STOP_AFTER <= 1) return;
    if (STOP_AFTER <= 1) return;
    mixer_chunk<0>(xbar, lds, G, gw, NGW, H, Win, Wa, Wb, Wout, proj, og, lse, oa, ob, Z, Dbuf, rope, a.in[10], a.in[11]);
    mixer_chunk<1>(xbar, lds, G, gw, NGW, H, Win, Wa, Wb, Wout, proj, og, lse, oa, ob, Z, Dbuf, rope, a.in[10], a.in[11]);
    mixer_chunk<2>(xbar, lds, G, gw, NGW, H, Win, Wa, Wb, Wout, proj, og, lse, oa, ob, Z, Dbuf, rope, a.in[10], a.in[11]);
    GSYNC();
    row_pass<true, true, true, true>(nullptr, nullptr, XB, Dbuf, a.in[8], 1.0f, nullptr, XB, a.in[15], H, lane, gw, NGW);
    GSYNC();
    if (STOP_AFTER <= 2) return;
    if (STOP_AFTER <= 2) return;
    { pg8::Gemm g{H, Wgu2, TALL, 2 * FF, DM}; SO.init(TALL, 2 * FF, G, blockIdx.x); EpiSwiglu E{A1}; pg8::gemm_phase(lds, g, SO, E); }
    GSYNC();
    { pg8::Gemm g{A1, Wd2, TALL, DM, FF}; SO.init(TALL, DM, G, blockIdx.x); EpiPlain E{Dbuf, DM}; pg8::gemm_phase(lds, g, SO, E); }
    GSYNC();
    row_pass<true, false, true, false>(nullptr, nullptr, XB, Dbuf, a.in[16], 0.5f, out, nullptr, nullptr, nullptr, lane, gw, NGW);
}

extern "C" void kernel_launch(void* const* d_in, const int* in_sizes, int n_in, void* d_out, int out_size, void* d_ws, size_t ws_size, hipStream_t stream) {
    static int grid = 0;
    if (grid == 0) {
        if (n_in != 20 || out_size != TALL * DM || ws_size < WS_END) { fprintf(stderr, "kernel_launch: unexpected shapes (n_in %d out %d ws %zu)\n", n_in, out_size, ws_size); grid = -1; return; }
        int dev = 0, cus = 0, per_cu = 0;
        hipGetDevice(&dev);
        hipDeviceGetAttribute(&cus, hipDeviceAttributeMultiprocessorCount, dev);
        hipFuncSetAttribute((const void*)enc_fwd, hipFuncAttributeMaxDynamicSharedMemorySize, LDS_BYTES);
        hipOccupancyMaxActiveBlocksPerMultiprocessor(&per_cu, (const void*)enc_fwd, NTHR, LDS_BYTES);
        if (per_cu < 1) per_cu = 1;
        grid = cus * per_cu;
        (void)hipGetLastError();
    }
    if (grid < 0) return;
    if (hipMemsetAsync((char*)d_ws + WS_BAR, 0, 16384, stream) != hipSuccess) { fprintf(stderr, "memset of barrier words failed\n"); return; }
    Args a{};
    for (int i = 0; i < 20; ++i) a.in[i] = (const float*)d_in[i];
    a.out = (float*)d_out; a.ws = (unsigned char*)d_ws;
    void* args[] = {&a};
    hipError_t e = hipLaunchCooperativeKernel((const void*)enc_fwd, dim3(grid), dim3(NTHR), args, LDS_BYTES, stream);
    if (e != hipSuccess) fprintf(stderr, "cooperative launch failed: %s (grid %d)\n", hipGetErrorString(e), grid);
}
```

```cpp
#include <hip/hip_runtime.h>
#include <hip/hip_cooperative_groups.h>
#include <cstdio>
#include <cstdint>
namespace cg = cooperative_groups;

#define LAS __attribute__((address_space(3)))
typedef unsigned short bf16_t;
typedef short bf16x8 __attribute__((ext_vector_type(8)));
typedef short s16x4 __attribute__((ext_vector_type(4)));
typedef float f32x4 __attribute__((ext_vector_type(4)));
typedef float f32x16 __attribute__((ext_vector_type(16)));
typedef unsigned u32x4 __attribute__((ext_vector_type(4)));
typedef unsigned u32x2 __attribute__((ext_vector_type(2)));

constexpr int DM = 1024, FF = 2816, TALL = 49152, TP = 16384, TC = 16384, NCH = 3;
constexpr int INW = 5888, GOFF = 3840;
constexpr int HSL = TC * 64;
constexpr int GPITCH = 2048;
constexpr int NWAVES = 8, NTHR = 512;
constexpr float RMS_EPS = 1e-6f;
constexpr float LOG2E = 1.4426950408889634f;
constexpr float QSCALE = 0.125f * LOG2E;
constexpr float NEGBIG = -1e30f;

constexpr size_t MiB = 1u << 20;
constexpr size_t WS_WGU1 = 0, WS_WD1 = 11 * MiB, WS_WIN = 16 * MiB + MiB / 2, WS_WA = 28 * MiB, WS_WB = 28 * MiB + MiB / 2, WS_WOUT = 29 * MiB + MiB / 2,
                 WS_WGU2 = 31 * MiB + MiB / 2, WS_WD2 = 42 * MiB + MiB / 2, WS_ROPE = 48 * MiB, WS_LSE = 49 * MiB;
constexpr size_t WS_H = 50 * MiB;
constexpr size_t WS_A1 = 146 * MiB;
constexpr size_t WS_D = WS_H;
constexpr size_t WS_XB = 410 * MiB;
constexpr size_t WS_BAR = 506 * MiB;
constexpr size_t WS_END = 507 * MiB;
constexpr size_t WS_PROJ = 146 * MiB;
constexpr size_t WS_OG = 330 * MiB;
constexpr size_t WS_OA = 354 * MiB;
constexpr size_t WS_OB = 362 * MiB;
constexpr size_t WS_Z = 378 * MiB;

#ifndef STOP_AFTER
#define STOP_AFTER 99
#endif
#ifndef SKIP_A
#define SKIP_A 0
#endif
#ifndef SKIP_B
#define SKIP_B 0
#endif
constexpr int LDS_BYTES = 131072 + 16384;

typedef float f32x2_t __attribute__((ext_vector_type(2))); typedef __bf16 bf16x2_t __attribute__((ext_vector_type(2)));
__device__ __forceinline__ unsigned cvt_pk_bf16(float lo, float hi) { f32x2_t v = {lo, hi}; bf16x2_t b = __builtin_convertvector(v, bf16x2_t); return __builtin_bit_cast(unsigned, b); }
__device__ __forceinline__ float bf_lo(unsigned u) { return __uint_as_float(u << 16); }
__device__ __forceinline__ float bf_hi(unsigned u) { return __uint_as_float(u & 0xffff0000u); }
__device__ __forceinline__ float fexp2(float x) { return __builtin_amdgcn_exp2f(x); }
__device__ __forceinline__ float frcp(float x) { return __builtin_amdgcn_rcpf(x); }
__device__ __forceinline__ float sigmoidf_(float x) { return frcp(1.0f + fexp2(-x * LOG2E)); }
__device__ __forceinline__ float wave_sum(float v) {
#pragma unroll
    for (int o = 1; o < 64; o <<= 1) v += __shfl_xor(v, o);
    return v;
}

namespace pg8 {
constexpr int BM = 256, BK = 64, HALF = 128, HTB = HALF * BK * 2, STAGE_BYTES = 8 * HTB, NXCD = 8, WGM = 8;
__host__ __device__ __forceinline__ int lds_byte(int r, int c) { const int st = (r >> 4) * 2 + (c >> 5), rr = r & 15, cc = c & 31, ob = rr * 64 + cc * 2; return st * 1024 + (ob ^ (((ob >> 9) & 1) << 5)); }
__host__ __device__ __forceinline__ void stage_rc(int b, int& R, int& C) { const int st = b / 1024, sb = b % 1024, swz = sb ^ (((sb >> 9) & 1) << 5); R = (st >> 1) * 16 + swz / 64; C = (st & 1) * 32 + (swz % 64) / 2; }
__host__ __device__ __forceinline__ int perm32(int rho) { const int n = rho >> 4, i = rho & 15; return 8 * (i >> 2) + 4 * n + (i & 3); }

struct Unit { int pm, pn; };
struct Gemm { const bf16_t* A; const bf16_t* Bt; int M, N, K; };

struct StaticOrder {
    int nM, nN, nwg, G, c;
    __device__ void init(int M, int N, int G_, int c_) { nM = M / BM; nN = N / BM; nwg = nM * nN; G = G_; c = c_; }
    __device__ bool next(int i, Unit& u) const {
        const long L = (long)i * G + c; if (L >= nwg) return false;
        int wgid = (int)L; { const int q = nwg / NXCD, r = nwg % NXCD, xcd = wgid % NXCD, off = wgid / NXCD; wgid = (xcd < r ? xcd * (q + 1) : r * (q + 1) + (xcd - r) * q) + off; }
        const int nig = WGM * nN, gid = wgid / nig, fm = gid * WGM, gsz = (nM - fm) < WGM ? (nM - fm) : WGM;
        u.pm = fm + ((wgid % nig) % gsz); u.pn = (wgid % nig) / gsz; return true;
    }
};

template <class Epi>
__device__ __forceinline__ void gemm_phase(LAS unsigned char* lds, const Gemm g, const StaticOrder& S, const Epi& E) {
    int tid_ = threadIdx.x; asm volatile("" : "+v"(tid_));
    const int tid = tid_, wid = __builtin_amdgcn_readfirstlane(tid >> 6), lane = tid & 63, wr = wid >> 2, wc = wid & 3, fr = lane & 15, fq = lane >> 4;
    const int K = g.K, nt = K / BK;
    unsigned voffA[2], voffB[2];
#pragma unroll
    for (int i = 0; i < 2; ++i) { int R, C; stage_rc(tid * 16 + i * 8192, R, C); const int Rb = (R & ~31) + perm32(R & 31);
        voffA[i] = (unsigned)(R * K + C) * 2u; voffB[i] = (unsigned)(Rb * K + C) * 2u; }
    const size_t kstep = (size_t)(BK * 2);
    const size_t hstep = (size_t)HALF * K * 2;
    const size_t tstep = 2 * hstep;
    const unsigned ldsw = (unsigned)wid * 1024u;
    const int aoff = lds_byte(wr * 64 + fr, fq * 8), boff = lds_byte(wc * 32 + fr, fq * 8);
#define PG8_SA(b, h) (((b) * 2 + (h)) * HTB)
#define PG8_SB(b, h) ((4 + (b) * 2 + (h)) * HTB)
#define PG8_STAGE(bufoff, gbase, voff) do { _Pragma("unroll") for (int _i = 0; _i < 2; ++_i) \
        __builtin_amdgcn_global_load_lds((const __attribute__((address_space(1))) unsigned*)((const char*)(gbase) + (voff)[_i]), (LAS unsigned*)(lds + (bufoff) + ldsw + _i * 8192), 16, 0, 0); } while (0)
#define PG8_LDA(dst, b, h) do { _Pragma("unroll") for (int m = 0; m < 4; ++m) _Pragma("unroll") for (int k = 0; k < 2; ++k) dst[m][k] = *(const LAS bf16x8*)(lds + PG8_SA(b, h) + aoff + m * 2048 + k * 1024); } while (0)
#define PG8_LDB(dst, b, h) do { _Pragma("unroll") for (int n = 0; n < 2; ++n) _Pragma("unroll") for (int k = 0; k < 2; ++k) dst[n][k] = *(const LAS bf16x8*)(lds + PG8_SB(b, h) + boff + n * 2048 + k * 1024); } while (0)
#define PG8_MMA(ai, bj, At, Bt) do { __builtin_amdgcn_s_setprio(1); _Pragma("unroll") for (int m = 0; m < 4; ++m) _Pragma("unroll") for (int n = 0; n < 2; ++n) _Pragma("unroll") for (int k = 0; k < 2; ++k) \
        acc[ai][bj][m][n] = __builtin_amdgcn_mfma_f32_16x16x32_bf16(Bt[n][k], At[m][k], acc[ai][bj][m][n], 0, 0, 0); __builtin_amdgcn_s_setprio(0); } while (0)
#define PG8_WAIT_V(n) asm volatile("s_waitcnt vmcnt(" #n ")" ::: "memory")
#define PG8_WAIT_L(n) asm volatile("s_waitcnt lgkmcnt(" #n ")" ::: "memory")
#define PG8_BAR __builtin_amdgcn_s_barrier()
#define PG8_SCHED __builtin_amdgcn_sched_barrier(0)
    Unit cur, nxt; int ui = 0;
    if (!S.next(0, cur)) return;
    f32x4 acc[2][2][4][2];
#pragma unroll
    for (int a = 0; a < 2; ++a)
#pragma unroll
        for (int b = 0; b < 2; ++b)
#pragma unroll
            for (int m = 0; m < 4; ++m)
#pragma unroll
                for (int n = 0; n < 2; ++n) acc[a][b][m][n] = (f32x4){0.f, 0.f, 0.f, 0.f};
    bf16x8 At[4][2], B0[2][2], B1[2][2];
    const char* cA = (const char*)g.A + (size_t)cur.pm * tstep; const char* cB = (const char*)g.Bt + (size_t)cur.pn * tstep;
    PG8_STAGE(PG8_SB(0, 0), cB, voffB); PG8_STAGE(PG8_SB(0, 1), cB + hstep, voffB); PG8_STAGE(PG8_SA(0, 0), cA, voffA); PG8_STAGE(PG8_SA(0, 1), cA + hstep, voffA);
    if (wr == 1) PG8_BAR;
    PG8_WAIT_V(2); PG8_BAR;
    PG8_STAGE(PG8_SB(1, 0), cB + kstep, voffB); PG8_STAGE(PG8_SA(1, 0), cA + kstep, voffA); PG8_STAGE(PG8_SB(1, 1), cB + hstep + kstep, voffB);
    PG8_WAIT_V(6); PG8_BAR;
    for (;;) {
        const bool has_next = S.next(ui + 1, nxt);
        const char* nA = has_next ? (const char*)g.A + (size_t)nxt.pm * tstep : cA; const char* nB = has_next ? (const char*)g.Bt + (size_t)nxt.pn * tstep : cB;
#pragma nounroll
        for (int t = 0; t < nt; t += 2) {
            const bool last = (t == nt - 2);
            const char* a1 = cA + (size_t)(t + 1) * kstep;
            const char* a2 = last ? nA : cA + (size_t)(t + 2) * kstep; const char* b2 = last ? nB : cB + (size_t)(t + 2) * kstep;
            const char* a3 = a2 + kstep; const char* b3 = b2 + kstep;
            PG8_LDB(B0, 0, 0); PG8_LDB(B1, 0, 1); PG8_SCHED; PG8_LDA(At, 0, 0); PG8_STAGE(PG8_SA(1, 1), a1 + hstep, voffA);
            PG8_WAIT_V(8); PG8_WAIT_L(0); PG8_BAR; PG8_MMA(0, 0, At, B0); PG8_MMA(0, 1, At, B1); PG8_BAR; PG8_SCHED;
            PG8_LDA(At, 0, 1); PG8_STAGE(PG8_SB(0, 0), b2, voffB); PG8_STAGE(PG8_SB(0, 1), b2 + hstep, voffB); PG8_STAGE(PG8_SA(0, 0), a2, voffA);
            PG8_WAIT_V(8); PG8_WAIT_L(0); PG8_BAR; PG8_MMA(1, 0, At, B0); PG8_MMA(1, 1, At, B1); PG8_BAR; PG8_SCHED;
            PG8_LDB(B0, 1, 0); PG8_LDB(B1, 1, 1); PG8_SCHED; PG8_LDA(At, 1, 0); PG8_STAGE(PG8_SA(0, 1), a2 + hstep, voffA);
            PG8_WAIT_V(8); PG8_WAIT_L(0); PG8_BAR; PG8_MMA(0, 0, At, B0); PG8_MMA(0, 1, At, B1); PG8_BAR; PG8_SCHED;
            PG8_LDA(At, 1, 1); PG8_STAGE(PG8_SB(1, 0), b3, voffB); PG8_STAGE(PG8_SB(1, 1), b3 + hstep, voffB); PG8_STAGE(PG8_SA(1, 0), a3, voffA);
            PG8_WAIT_V(8); PG8_WAIT_L(0); PG8_BAR; PG8_MMA(1, 0, At, B0); PG8_MMA(1, 1, At, B1); PG8_BAR; PG8_SCHED;
        }
        if (wr == 0) PG8_BAR;
        E(acc, cur, wr, wc, fr, fq);
        if (!has_next) break;
#pragma unroll
        for (int a = 0; a < 2; ++a)
#pragma unroll
            for (int b = 0; b < 2; ++b)
#pragma unroll
                for (int m = 0; m < 4; ++m)
#pragma unroll
                    for (int n = 0; n < 2; ++n) acc[a][b][m][n] = (f32x4){0.f, 0.f, 0.f, 0.f};
        cur = nxt; cA = nA; cB = nB; ++ui;
        if (wr == 1) PG8_BAR;
    }
    PG8_WAIT_V(0);
    PG8_BAR;
#undef PG8_SA
#undef PG8_SB
#undef PG8_STAGE
#undef PG8_LDA
#undef PG8_LDB
#undef PG8_MMA
#undef PG8_WAIT_V
#undef PG8_WAIT_L
#undef PG8_BAR
#undef PG8_SCHED
}
}
using pg8::Unit;

typedef f32x4 AccT[2][2][4][2];

#define OPAQUE(o) asm volatile("" : "+v"(o))
struct EpiPlain {
    bf16_t* O; int ldc;
    __device__ __forceinline__ void operator()(const AccT& acc, const Unit& u, int wr, int wc, int fr, int fq) const {
        const unsigned lo = (unsigned)((u.pm * 256 + wr * 64 + fr) * ldc + u.pn * 256 + wc * 32 + 8 * fq) * 2u;
#pragma unroll
        for (int ai = 0; ai < 2; ++ai)
#pragma unroll
            for (int m = 0; m < 4; ++m) { unsigned o = lo + (unsigned)((ai * 128 + m * 16) * ldc) * 2u; OPAQUE(o); char* rowp = (char*)O + o;
#pragma unroll
                for (int bj = 0; bj < 2; ++bj) { const f32x4 v0 = acc[ai][bj][m][0], v1 = acc[ai][bj][m][1];
                    u32x4 w; w.x = cvt_pk_bf16(v0[0], v0[1]); w.y = cvt_pk_bf16(v0[2], v0[3]); w.z = cvt_pk_bf16(v1[0], v1[1]); w.w = cvt_pk_bf16(v1[2], v1[3]);
                    *(u32x4*)(rowp + bj * 256) = w; } }
    }
};
struct EpiSwiglu {
    bf16_t* O;
    __device__ __forceinline__ void operator()(const AccT& acc, const Unit& u, int wr, int wc, int fr, int fq) const {
        const unsigned lo = (unsigned)((u.pm * 256 + wr * 64 + fr) * FF + u.pn * 128 + wc * 32 + 8 * fq) * 2u;
#pragma unroll
        for (int ai = 0; ai < 2; ++ai)
#pragma unroll
            for (int m = 0; m < 4; ++m) { unsigned o = lo + (unsigned)((ai * 128 + m * 16) * FF) * 2u; OPAQUE(o); char* rowp = (char*)O + o;
                float r[8];
#pragma unroll
                for (int n = 0; n < 2; ++n)
#pragma unroll
                    for (int j = 0; j < 4; ++j) { const float gt = acc[ai][0][m][n][j], up = acc[ai][1][m][n][j]; r[n * 4 + j] = gt * sigmoidf_(gt) * up; }
                u32x4 w; w.x = cvt_pk_bf16(r[0], r[1]); w.y = cvt_pk_bf16(r[2], r[3]); w.z = cvt_pk_bf16(r[4], r[5]); w.w = cvt_pk_bf16(r[6], r[7]);
                *(u32x4*)rowp = w; }
    }
};
struct EpiProj {
    bf16_t* O; const float* rope; const float* bgate; int posmask; int lgS;
    __device__ __forceinline__ void operator()(const AccT& acc, const Unit& u, int wr, int wc, int fr, int fq) const {
        const int pn = u.pn;
        const int row0 = u.pm * 256 + wr * 64 + fr, col0 = pn * 256 + wc * 32 + 8 * fq;
        const bool ropeTile = pn < 6, gateTile = pn >= 15;
        const float sc = (pn < 3 || pn == 9 || pn == 10) ? QSCALE : 1.0f;
        const bool rot = ropeTile && ((wc & 1) == 0) && (fq < 2);
        if (gateTile) {
            const unsigned lo = (unsigned)(3840 * TC + row0 * GPITCH + (col0 - GOFF)) * 2u;
#pragma unroll
            for (int bj = 0; bj < 2; ++bj) { const f32x4 b0 = *(const f32x4*)(bgate + col0 - GOFF + bj * 128), b1 = *(const f32x4*)(bgate + col0 - GOFF + bj * 128 + 4);
#pragma unroll
                for (int ai = 0; ai < 2; ++ai)
#pragma unroll
                    for (int m = 0; m < 4; ++m) { unsigned o = lo + (unsigned)((ai * 128 + m * 16) * GPITCH) * 2u + bj * 256; OPAQUE(o);
                        f32x4 v0 = acc[ai][bj][m][0] + b0, v1 = acc[ai][bj][m][1] + b1;
#pragma unroll
                        for (int j = 0; j < 4; ++j) { v0[j] = sigmoidf_(v0[j]); v1[j] = sigmoidf_(v1[j]); }
                        u32x4 w; w.x = cvt_pk_bf16(v0[0], v0[1]); w.y = cvt_pk_bf16(v0[2], v0[3]); w.z = cvt_pk_bf16(v1[0], v1[1]); w.w = cvt_pk_bf16(v1[2], v1[3]);
                        *(u32x4*)((char*)O + o) = w; } }
        } else {
            const int dsh = (pn < 9) ? 2 * (pn % 3) : 0;
            const int hs0 = pn * 4 + (wc >> 1);
            const unsigned hoff = (unsigned)(hs0 * HSL + 32 * (wc & 1) + 8 * fq) * 2u;
#pragma unroll
            for (int ai = 0; ai < 2; ++ai) {
                f32x4 csv[4], snv[4];
#pragma unroll
                for (int m = 0; m < 4; ++m) { csv[m] = (f32x4){1.f, 1.f, 1.f, 1.f}; snv[m] = (f32x4){0.f, 0.f, 0.f, 0.f}; }
                if (ropeTile) {
#pragma unroll
                    for (int m = 0; m < 4; ++m) { unsigned ro = (unsigned)(((row0 + ai * 128 + m * 16) & posmask) * 16 + 4 * (fq & 1)) * 4u; OPAQUE(ro);
                        const f32x4 c = *(const f32x4*)((const char*)rope + ro), s = *(const f32x4*)((const char*)rope + ro + 32);
                        csv[m] = rot ? c : csv[m]; snv[m] = rot ? s : snv[m]; }
                }
#pragma unroll
                for (int m = 0; m < 4; ++m) { const int row = row0 + ai * 128 + m * 16, t = row & posmask;
                    const int pos = (row - t) + ((t & ((1 << dsh) - 1)) << (lgS - dsh)) + (t >> dsh);
                    unsigned o = hoff + (unsigned)pos * 128u; OPAQUE(o);
                    const f32x4 cs = csv[m], sn = snv[m];
#pragma unroll
                    for (int bj = 0; bj < 2; ++bj) { f32x4 v0 = acc[ai][bj][m][0], v1 = acc[ai][bj][m][1];
                        if (ropeTile) { const f32x4 x1 = v0, x2 = v1; v0 = x1 * cs - x2 * sn; v1 = x2 * cs + x1 * sn; }
                        v0 = v0 * sc; v1 = v1 * sc;
                        u32x4 w; w.x = cvt_pk_bf16(v0[0], v0[1]); w.y = cvt_pk_bf16(v0[2], v0[3]); w.z = cvt_pk_bf16(v1[0], v1[1]); w.w = cvt_pk_bf16(v1[2], v1[3]);
                        *(u32x4*)((char*)O + o + (unsigned)(bj * 2 * HSL) * 2u) = w; }
                    asm volatile("" ::: "memory"); }
            }
        }
    }
};
template <bool ADD> struct EpiGate {
    bf16_t* Z; const bf16_t* P; int goff;
    __device__ __forceinline__ void operator()(const AccT& acc, const Unit& u, int wr, int wc, int fr, int fq) const {
        constexpr int RB = ADD ? 2 : 4;
        const int row0 = u.pm * 256 + wr * 64 + fr, col0 = u.pn * 256 + wc * 32 + 8 * fq;
        const unsigned zl = (unsigned)(row0 * DM + col0) * 2u, gl = (unsigned)(3840 * TC + row0 * GPITCH + goff + col0) * 2u;
#pragma unroll
        for (int ai = 0; ai < 2; ++ai)
#pragma unroll
            for (int mb = 0; mb < 4; mb += RB) {
                u32x4 gw[RB][2], zo[RB][2]; unsigned zoff[RB];
#pragma unroll
                for (int k = 0; k < RB; ++k) { const int m = mb + k;
                    unsigned zo_ = zl + (unsigned)((ai * 128 + m * 16) * DM) * 2u, go_ = gl + (unsigned)((ai * 128 + m * 16) * GPITCH) * 2u; OPAQUE(zo_); OPAQUE(go_);
                    zoff[k] = zo_;
#pragma unroll
                    for (int bj = 0; bj < 2; ++bj) { gw[k][bj] = *(const u32x4*)((const char*)P + go_ + bj * 256); if (ADD) zo[k][bj] = *(const u32x4*)((const char*)Z + zo_ + bj * 256); } }
#pragma unroll
                for (int k = 0; k < RB; ++k) { const int m = mb + k;
#pragma unroll
                    for (int bj = 0; bj < 2; ++bj) { const f32x4 v0 = acc[ai][bj][m][0], v1 = acc[ai][bj][m][1]; const u32x4 g = gw[k][bj];
                        float r[8];
                        r[0] = bf_lo(g.x) * v0[0]; r[1] = bf_hi(g.x) * v0[1]; r[2] = bf_lo(g.y) * v0[2]; r[3] = bf_hi(g.y) * v0[3];
                        r[4] = bf_lo(g.z) * v1[0]; r[5] = bf_hi(g.z) * v1[1]; r[6] = bf_lo(g.w) * v1[2]; r[7] = bf_hi(g.w) * v1[3];
                        if (ADD) { const u32x4 z = zo[k][bj];
                            r[0] += bf_lo(z.x); r[1] += bf_hi(z.x); r[2] += bf_lo(z.y); r[3] += bf_hi(z.y); r[4] += bf_lo(z.z); r[5] += bf_hi(z.z); r[6] += bf_lo(z.w); r[7] += bf_hi(z.w); }
                        u32x4 w; w.x = cvt_pk_bf16(r[0], r[1]); w.y = cvt_pk_bf16(r[2], r[3]); w.z = cvt_pk_bf16(r[4], r[5]); w.w = cvt_pk_bf16(r[6], r[7]);
                        *(u32x4*)((char*)Z + zoff[k] + bj * 256) = w; } }
                asm volatile("" ::: "memory"); }
    }
};

struct Args {
    const float* in[20];
    float* out;
    unsigned char* ws;
};

__device__ __forceinline__ void transpose_item(const float* W, int ldw, int sc, bf16_t* WT, int K, int n0, int k0, LAS float* scr, int lane) {
    float tv[32];
#pragma unroll
    for (int i = 0; i < 32; ++i) tv[i] = W[(size_t)(k0 + 2 * i + (lane >> 5)) * ldw + sc];
#pragma unroll
    for (int i = 0; i < 32; ++i) scr[(2 * i + (lane >> 5)) * 33 + (lane & 31)] = tv[i];
    asm volatile("s_waitcnt lgkmcnt(0)" ::: "memory");
    const int c = lane & 7;
#pragma unroll
    for (int j = 0; j < 4; ++j) { const int n = (lane >> 3) + 8 * j; const LAS float* s = scr + (8 * c) * 33 + n;
        u32x4 o; o.x = cvt_pk_bf16(s[0 * 33], s[1 * 33]); o.y = cvt_pk_bf16(s[2 * 33], s[3 * 33]); o.z = cvt_pk_bf16(s[4 * 33], s[5 * 33]); o.w = cvt_pk_bf16(s[6 * 33], s[7 * 33]);
        *(u32x4*)(WT + (size_t)(n0 + n) * K + k0 + 8 * c) = o; }
    asm volatile("s_waitcnt lgkmcnt(0)" ::: "memory");
}
template <int KIND>
__device__ __forceinline__ void transpose_items(const float* W0, const float* W1, int ldw, bf16_t* WT, int K, int N, LAS float* scr, int lane, int gw, int NGW) {
    const int nblk = N / 32, nitems = (K / 64) * nblk;
    for (int it = gw; it < nitems; it += NGW) {
        const int kb = it / nblk, nb = it % nblk, n0 = nb * 32, n = n0 + (lane & 31);
        const float* W = W0; int sc = n;
        if (KIND == 1) { const int tile = n >> 8, bj = (n >> 7) & 1, j = n & 127; W = bj ? W1 : W0; sc = tile * 128 + j; }
        if (KIND == 2) { if (n < 1536 && (n & 63) < 16) { const int p = n & 15; const int d = (p < 8) ? ((p & 3) + ((p >> 2) << 3)) : (4 + (p & 3) + (((p - 8) >> 2) << 3)); sc = (n & ~15) + d; } }
        transpose_item(W, ldw, sc, WT, K, n0, kb * 64, scr, lane);
    }
}

template <bool HAS_D, bool HAS_H, bool XIN16, bool XOUT16>
__device__ __forceinline__ void row_pass(const float* xa, const float* xb, const bf16_t* x16in, const bf16_t* D, const float* gpost, float dscale, float* xout, bf16_t* x16out, const float* gpre, bf16_t* hout, int lane, int gw, int NGW) {
    f32x4 gp[4], gq[4];
#pragma unroll
    for (int j = 0; j < 4; ++j) { if (HAS_D) gp[j] = *(const f32x4*)(gpost + 4 * lane + 256 * j); if (HAS_H) gq[j] = *(const f32x4*)(gpre + 4 * lane + 256 * j); }
    for (int row = gw; row < TALL; row += NGW) {
        f32x4 v[4];
        if (XIN16) {
#pragma unroll
            for (int j = 0; j < 4; ++j) { const u32x2 w = *(const u32x2*)(x16in + (size_t)row * DM + 4 * lane + 256 * j); v[j] = (f32x4){bf_lo(w.x), bf_hi(w.x), bf_lo(w.y), bf_hi(w.y)}; }
        } else {
            const float* xr = (row < TP) ? xa + (size_t)row * DM : xb + (size_t)(row - TP) * DM;
#pragma unroll
            for (int j = 0; j < 4; ++j) v[j] = *(const f32x4*)(xr + 4 * lane + 256 * j);
        }
        if (HAS_D) {
            f32x4 d[4]; float ss = 0.f;
#pragma unroll
            for (int j = 0; j < 4; ++j) { const u32x2 w = *(const u32x2*)(D + (size_t)row * DM + 4 * lane + 256 * j);
                d[j] = (f32x4){bf_lo(w.x), bf_hi(w.x), bf_lo(w.y), bf_hi(w.y)}; ss += (d[j][0] * d[j][0] + d[j][1] * d[j][1]) + (d[j][2] * d[j][2] + d[j][3] * d[j][3]); }
            const float r = dscale * __builtin_amdgcn_rsqf(wave_sum(ss) * (1.0f / DM) + RMS_EPS);
#pragma unroll
            for (int j = 0; j < 4; ++j) { v[j] = v[j] + d[j] * gp[j] * r;
                if (XOUT16) { u32x2 w; w.x = cvt_pk_bf16(v[j][0], v[j][1]); w.y = cvt_pk_bf16(v[j][2], v[j][3]); *(u32x2*)(x16out + (size_t)row * DM + 4 * lane + 256 * j) = w; }
                else *(f32x4*)(xout + (size_t)row * DM + 4 * lane + 256 * j) = v[j]; }
        }
        if (HAS_H) {
            float ss = 0.f;
#pragma unroll
            for (int j = 0; j < 4; ++j) ss += (v[j][0] * v[j][0] + v[j][1] * v[j][1]) + (v[j][2] * v[j][2] + v[j][3] * v[j][3]);
            const float r = __builtin_amdgcn_rsqf(wave_sum(ss) * (1.0f / DM) + RMS_EPS);
#pragma unroll
            for (int j = 0; j < 4; ++j) { const f32x4 o = v[j] * gq[j] * r; u32x2 w; w.x = cvt_pk_bf16(o[0], o[1]); w.y = cvt_pk_bf16(o[2], o[3]);
                *(u32x2*)(hout + (size_t)row * DM + 4 * lane + 256 * j) = w; }
        }
    }
}

constexpr int WAVE_LDS = 16384;
constexpr int RPB_OFF = 131072;
__device__ __forceinline__ int crow(int r, int hi) { return (r & 3) + 8 * (r >> 2) + 4 * hi; }
__device__ __forceinline__ s16x4 vtr(LAS const unsigned char* p) { return __builtin_bit_cast(s16x4, __builtin_amdgcn_ds_read_tr16_b64_v4i16((LAS s16x4*)p)); }

struct KVRegs { u32x4 k[4], v[4]; };
#define F16Z (f32x16){0.f,0.f,0.f,0.f,0.f,0.f,0.f,0.f,0.f,0.f,0.f,0.f,0.f,0.f,0.f,0.f}

#define ATT_LOAD(R, posexpr) do { _Pragma("unroll") for (int _i = 0; _i < 4; ++_i) { const int _rowi = (lane >> 3) + 8 * _i; const size_t _off = (size_t)(posexpr) * 64 + 8 * (lane & 7); \
        R.k[_i] = *(const u32x4*)(kbase + _off); R.v[_i] = *(const u32x4*)(vbase + _off); } } while (0)
#define ATT_STORE(R, slot) do { _Pragma("unroll") for (int _i = 0; _i < 4; ++_i) { \
        *(LAS u32x4*)(wl + (slot) * 8192 + wst + _i * 1024) = R.k[_i]; *(LAS u32x4*)(wl + (slot) * 8192 + 4096 + wst + _i * 1024) = R.v[_i]; } } while (0)
#define ATT_QK(s, slot) do { s = F16Z; _Pragma("unroll") for (int _d = 0; _d < 4; ++_d) { \
        const bf16x8 _kf = *(const LAS bf16x8*)(wl + (slot) * 8192 + q32 * 128 + ((kx ^ (2 * _d)) << 4)); s = __builtin_amdgcn_mfma_f32_32x32x16_bf16(_kf, qr[_d], s, 0, 0, 0); } } while (0)
#define ATT_PACK(p0, p1, s) do { u32x4 _a, _b; _a.x = cvt_pk_bf16(s[0], s[1]); _a.y = cvt_pk_bf16(s[2], s[3]); _a.z = cvt_pk_bf16(s[4], s[5]); _a.w = cvt_pk_bf16(s[6], s[7]); \
        _b.x = cvt_pk_bf16(s[8], s[9]); _b.y = cvt_pk_bf16(s[10], s[11]); _b.z = cvt_pk_bf16(s[12], s[13]); _b.w = cvt_pk_bf16(s[14], s[15]); \
        p0 = __builtin_bit_cast(bf16x8, _a); p1 = __builtin_bit_cast(bf16x8, _b); } while (0)
#define ATT_PV(slot, p0, p1) do { LAS const unsigned char* _v0 = wl + (slot) * 8192 + 4096 + vb0; LAS const unsigned char* _v1 = wl + (slot) * 8192 + 4096 + (vb0 ^ 64); \
        { const s16x4 a = vtr(_v0), b = vtr(_v0 + 1024); const bf16x8 vf = (bf16x8){a[0], a[1], a[2], a[3], b[0], b[1], b[2], b[3]}; oT0 = __builtin_amdgcn_mfma_f32_32x32x16_bf16(vf, p0, oT0, 0, 0, 0); } \
        { const s16x4 a = vtr(_v1), b = vtr(_v1 + 1024); const bf16x8 vf = (bf16x8){a[0], a[1], a[2], a[3], b[0], b[1], b[2], b[3]}; oT1 = __builtin_amdgcn_mfma_f32_32x32x16_bf16(vf, p0, oT1, 0, 0, 0); } \
        { const s16x4 a = vtr(_v0 + 2048), b = vtr(_v0 + 3072); const bf16x8 vf = (bf16x8){a[0], a[1], a[2], a[3], b[0], b[1], b[2], b[3]}; oT0 = __builtin_amdgcn_mfma_f32_32x32x16_bf16(vf, p1, oT0, 0, 0, 0); } \
        { const s16x4 a = vtr(_v1 + 2048), b = vtr(_v1 + 3072); const bf16x8 vf = (bf16x8){a[0], a[1], a[2], a[3], b[0], b[1], b[2], b[3]}; oT1 = __builtin_amdgcn_mfma_f32_32x32x16_bf16(vf, p1, oT1, 0, 0, 0); } } while (0)
#define ATT_SOFTMAX_PV(NT, sA, sB) do { \
        float _tm = sA[0]; _Pragma("unroll") for (int _r = 1; _r < 16; ++_r) _tm = fmaxf(_tm, sA[_r]); \
        if (NT == 2) { _Pragma("unroll") for (int _r = 0; _r < 16; ++_r) _tm = fmaxf(_tm, sB[_r]); } \
        _tm = fmaxf(_tm, __shfl_xor(_tm, 32)); \
        if (__any(_tm > m_run)) { const float _mn = fmaxf(m_run, _tm), _al = fexp2(m_run - _mn); m_run = _mn; l_run *= _al; \
            _Pragma("unroll") for (int _r = 0; _r < 16; ++_r) { oT0[_r] *= _al; oT1[_r] *= _al; } } \
        float _sum = 0.f, _sum2 = 0.f; _Pragma("unroll") for (int _r = 0; _r < 16; ++_r) { sA[_r] = fexp2(sA[_r] - m_run); _sum += sA[_r]; } \
        if (NT == 2) { _Pragma("unroll") for (int _r = 0; _r < 16; ++_r) { sB[_r] = fexp2(sB[_r] - m_run); _sum2 += sB[_r]; } } \
        l_run += _sum + _sum2; \
        bf16x8 _pa0, _pa1; ATT_PACK(_pa0, _pa1, sA); ATT_PV(0, _pa0, _pa1); \
        if (NT == 2) { bf16x8 _pb0, _pb1; ATT_PACK(_pb0, _pb1, sB); ATT_PV(1, _pb0, _pb1); } \
    } while (0)
#define ATT_WRITE_O(orow) do { \
        _Pragma("unroll") for (int _g = 0; _g < 4; ++_g) { \
            u32x2 w0, w1; w0.x = cvt_pk_bf16(oT0[4 * _g] * inv, oT0[4 * _g + 1] * inv); w0.y = cvt_pk_bf16(oT0[4 * _g + 2] * inv, oT0[4 * _g + 3] * inv); \
            w1.x = cvt_pk_bf16(oT1[4 * _g] * inv, oT1[4 * _g + 1] * inv); w1.y = cvt_pk_bf16(oT1[4 * _g + 2] * inv, oT1[4 * _g + 3] * inv); \
            *(u32x2*)((orow) + 8 * _g + 4 * hi) = w0; *(u32x2*)((orow) + 32 + 8 * _g + 4 * hi) = w1; } } while (0)
#define ATT_LANE_SETUP() \
    const int q32 = lane & 31, hi = lane >> 5; \
    const int wst = (lane >> 3) * 128 + (((lane & 7) ^ ((lane >> 3) & 7)) << 4);                         \
    const int kx = hi ^ (q32 & 7);                                                                        \
    const int vb0 = (4 * hi + ((lane & 15) >> 2)) * 128 + (((2 * ((lane >> 4) & 1) + ((lane & 3) >> 1)) ^ ((4 * hi + ((lane & 15) >> 2)) & 7)) << 4) + 8 * (lane & 1);

__device__ __forceinline__ void attnA_unit(int u, const bf16_t* proj, bf16_t* og, float* lse, int S, LAS unsigned char* wl, int lane) {
    ATT_LANE_SETUP()
    const int g = u / 2048, rem = u % 2048, h = rem / 512, idx = rem % 512;
    const int per_seq = S / 32, seq = idx / per_seq, ii = idx % per_seq;
    const int dsh = 2 * g, dl = 1 << dsh;
    const int r = ii & (dl - 1), c = ii >> dsh, L = S >> dsh;
    const int hd = 4 * g + h;
    const bf16_t* kbase = proj + (size_t)(12 + hd) * HSL; const bf16_t* vbase = proj + (size_t)(24 + hd) * HSL;
    const size_t seqbase = (size_t)seq * S;
    const size_t pbase = seqbase + (size_t)r * L;
    const int qm = 32 * c + q32;
    const size_t qtok = seqbase + (size_t)qm * dl + r;
    bf16x8 qr[4];
#pragma unroll
    for (int d = 0; d < 4; ++d) qr[d] = *(const bf16x8*)(proj + (size_t)hd * HSL + (pbase + qm) * 64 + 16 * d + 8 * hi);
    const int m0 = 32 * c - 64;
    float m_run = -1e29f, l_run = 0.f;
    f32x16 oT0 = F16Z, oT1 = F16Z;
    KVRegs Ra, Rb;
#define TOKA(t) (pbase + (size_t)min(max(m0 + 32 * (t) + _rowi, 0), L - 1))
#define A_MASK(s, t) do { const int kb0 = m0 + 32 * (t); \
        if (kb0 < 0 || kb0 + 32 > L) { \
            _Pragma("unroll") for (int rr = 0; rr < 16; ++rr) { const int km = kb0 + crow(rr, hi); const int dk = km - qm; \
                const bool ok = (km >= 0) && (km < L) && (dk <= 64) && (dk >= -64); s[rr] = ok ? s[rr] : NEGBIG; } \
        } else if ((t) == 0) { \
            _Pragma("unroll") for (int rr = 0; rr < 16; ++rr) s[rr] = (crow(rr, hi) >= q32) ? s[rr] : NEGBIG; \
        } else if ((t) == 4) { \
            _Pragma("unroll") for (int rr = 0; rr < 16; ++rr) s[rr] = (crow(rr, hi) <= q32) ? s[rr] : NEGBIG; \
        } } while (0)
    ATT_LOAD(Ra, TOKA(0)); ATT_LOAD(Rb, TOKA(1));
    ATT_STORE(Ra, 0); ATT_STORE(Rb, 1); ATT_LOAD(Ra, TOKA(2)); ATT_LOAD(Rb, TOKA(3));
    { f32x16 s0, s1; ATT_QK(s0, 0); ATT_QK(s1, 1); A_MASK(s0, 0); A_MASK(s1, 1); ATT_SOFTMAX_PV(2, s0, s1); }
    ATT_STORE(Ra, 0); ATT_STORE(Rb, 1); ATT_LOAD(Ra, TOKA(4));
    { f32x16 s0, s1; ATT_QK(s0, 0); ATT_QK(s1, 1); A_MASK(s0, 2); A_MASK(s1, 3); ATT_SOFTMAX_PV(2, s0, s1); }
    ATT_STORE(Ra, 0);
    { f32x16 s0; ATT_QK(s0, 0); A_MASK(s0, 4); ATT_SOFTMAX_PV(1, s0, s0); }
#undef A_MASK
#undef TOKA
    const float lt = l_run + __shfl_xor(l_run, 32);
    const float inv = frcp(lt);
    bf16_t* orow = og + qtok * 768 + hd * 64;
    ATT_WRITE_O(orow);
    if (hi == 0) lse[qtok * 12 + hd] = m_run + __builtin_amdgcn_logf(lt);
}

__device__ __forceinline__ void attnB_unit(int u, const bf16_t* proj, bf16_t* ob, int S, LAS unsigned char* wl, LAS const float* rpbL, int lane) {
    ATT_LANE_SETUP()
    const int h = u / 512, idx = u % 512;
    const int per_seq = S / 32, seq = idx / per_seq, ii = idx % per_seq;
    const int rp = ii >> 2, cc = ii & 3, rows = S / 64;
    const int ri0 = 2 * rp, qrow = ri0 + (q32 >> 4), qcolg = 16 * cc + (q32 & 15);
    const bf16_t* kbase = proj + (size_t)(44 + h) * HSL; const bf16_t* vbase = proj + (size_t)(52 + h) * HSL;
    const size_t seqbase = (size_t)seq * S;
    const size_t qtok = seqbase + (size_t)qrow * 64 + qcolg;
    bf16x8 qr[4];
#pragma unroll
    for (int d = 0; d < 4; ++d) qr[d] = *(const bf16x8*)(proj + (size_t)(36 + h) * HSL + qtok * 64 + 16 * d + 8 * hi);
    const int w0 = (cc == 0) ? 0 : (cc == 1) ? 8 : (cc == 2) ? 24 : 32;
    const int rs0 = min(max(ri0 - 4, 0), rows - 8), rs1 = min(max(ri0 - 3, 0), rows - 8);
    const int ntile = rs1 + 8 - rs0;
    const int rsq = min(max(qrow - 4, 0), rows - 8), csq = min(max(qcolg - 8, 0), 48);
    LAS const float* rb = rpbL + h * 465;
    const unsigned vmaskh = (0xFFFFu << (csq - w0)) >> (4 * hi);
    float m_run = -1e29f, l_run = 0.f;
    f32x16 oT0 = F16Z, oT1 = F16Z;
    KVRegs Ra, Rb;
#define TOKB(t) (seqbase + (size_t)(rs0 + (t)) * 64 + w0 + _rowi)
#define B_MASK(s, t) do { const int kr = rs0 + (t); const bool rowok = (kr >= rsq) && (kr < rsq + 8); \
        LAS const float* rbt = rb + ((kr - qrow + 7) * 31 + (w0 - qcolg + 15) + 4 * hi); \
        const unsigned mh = rowok ? vmaskh : 0u; float bv[16]; \
        _Pragma("unroll") for (int rr = 0; rr < 16; ++rr) bv[rr] = rbt[(rr & 3) + 8 * (rr >> 2)]; \
        _Pragma("unroll") for (int rr = 0; rr < 16; ++rr) { const int ko = (rr & 3) + 8 * (rr >> 2); const float sb = s[rr] + bv[rr]; s[rr] = (mh & (1u << ko)) ? sb : NEGBIG; } } while (0)
#define B_PAIR(t) do { f32x16 s0, s1; ATT_QK(s0, 0); ATT_QK(s1, 1); B_MASK(s0, (t)); B_MASK(s1, (t) + 1); ATT_SOFTMAX_PV(2, s0, s1); } while (0)
    ATT_LOAD(Ra, TOKB(0)); ATT_LOAD(Rb, TOKB(1));
    ATT_STORE(Ra, 0); ATT_STORE(Rb, 1); ATT_LOAD(Ra, TOKB(2)); ATT_LOAD(Rb, TOKB(3)); B_PAIR(0);
    ATT_STORE(Ra, 0); ATT_STORE(Rb, 1); ATT_LOAD(Ra, TOKB(4)); ATT_LOAD(Rb, TOKB(5)); B_PAIR(2);
    ATT_STORE(Ra, 0); ATT_STORE(Rb, 1); ATT_LOAD(Ra, TOKB(6)); ATT_LOAD(Rb, TOKB(7)); B_PAIR(4);
    ATT_STORE(Ra, 0); ATT_STORE(Rb, 1); if (ntile > 8) { ATT_LOAD(Ra, TOKB(8)); } B_PAIR(6);
    if (ntile > 8) { ATT_STORE(Ra, 0); f32x16 s0; ATT_QK(s0, 0); B_MASK(s0, 8); ATT_SOFTMAX_PV(1, s0, s0); }
#undef B_PAIR
#undef B_MASK
#undef TOKB
    const float lt = l_run + __shfl_xor(l_run, 32);
    const float inv = frcp(lt);
    bf16_t* orow = ob + qtok * 512 + h * 64;
    ATT_WRITE_O(orow);
}

#define XB_TMO      128
#define XB_XCNT(j)  (256  + 64 * (j))
#define XB_XSUB(j)  (1280 + 64 * (j))
#define XB_XGEN(j)  (2304 + 64 * (j))
#define XB_TOP      3328
#define XB_TOPGEN   3392
#define XCD_BAR_WORDS 3456
#define XB_SPIN_CAP (1u << 18)
__device__ __forceinline__ unsigned xb_ld(unsigned* p)              { return __hip_atomic_load(p, __ATOMIC_RELAXED, __HIP_MEMORY_SCOPE_AGENT); }
__device__ __forceinline__ unsigned xb_add(unsigned* p, unsigned v) { return __hip_atomic_fetch_add(p, v, __ATOMIC_RELAXED, __HIP_MEMORY_SCOPE_AGENT); }
__device__ __forceinline__ unsigned xb_xcc_id() { return (unsigned)__builtin_amdgcn_s_getreg((3 << 11) | 20) & 0xFu; }
#define XB_SPIN(cond, bar) do { unsigned _sp = 0; while (cond) { __builtin_amdgcn_s_sleep(1); \
    if ((++_sp & 255u) == 0u) { if (xb_ld(&(bar)[XB_TMO])) break; if (_sp > XB_SPIN_CAP) { atomicAdd(&(bar)[XB_TMO], 1u); break; } } } } while (0)
struct XcdBarrier { unsigned* bar; unsigned x; volatile LAS unsigned* st; };
__device__ __forceinline__ XcdBarrier xcd_barrier_post(unsigned* bar, volatile LAS unsigned* st) {
    XcdBarrier b; b.bar = bar; b.x = xb_xcc_id(); b.st = st;
    if (threadIdx.x == 0) (void)xb_add(&bar[XB_XCNT(b.x)], 1u);
    return b;
}
__device__ __forceinline__ void xcd_barrier_complete(unsigned* bar, unsigned x, unsigned& nloc, unsigned& nx) {
    const unsigned G = gridDim.x * gridDim.y * gridDim.z;
    unsigned sum, cnt, mine, sp = 0u;
    for (;;) {
        sum = 0u; cnt = 0u; mine = 0u;
#pragma unroll
        for (unsigned j = 0; j < 16; ++j) { const unsigned c = xb_ld(&bar[XB_XCNT(j)]); sum += c; cnt += (c > 0u) ? 1u : 0u; mine = (j == x) ? c : mine; }
        if (sum == G) break;
        __builtin_amdgcn_s_sleep(1);
        if ((++sp & 255u) == 0u) { if (xb_ld(&bar[XB_TMO])) break; if (sp > XB_SPIN_CAP) { atomicAdd(&bar[XB_TMO], 1u); break; } }
    }
    nloc = mine > 0u ? mine : 1u; nx = cnt > 0u ? cnt : 1u;
}
__device__ __forceinline__ void xcd_barrier(const XcdBarrier& b) {
    asm volatile("s_waitcnt vmcnt(0)" ::: "memory");
    __syncthreads();
    if (threadIdx.x == 0) {
        unsigned* bar = b.bar;
        __builtin_amdgcn_s_waitcnt(0);
        unsigned nloc = b.st[0], nx = b.st[1];
        if (nloc == 0u) { xcd_barrier_complete(bar, b.x, nloc, nx); b.st[0] = nloc; b.st[1] = nx; }
        const unsigned old = xb_add(&bar[XB_XSUB(b.x)], 1u);
        const unsigned gen = old / nloc;
        if (old + 1u == (gen + 1u) * nloc) {
            __builtin_amdgcn_fence(__ATOMIC_RELEASE, "agent");
            asm volatile("s_waitcnt vmcnt(0)" ::: "memory");
            const unsigned og = xb_add(&bar[XB_TOP], 1u);
            const unsigned tg = og / nx;
            if (og + 1u == (tg + 1u) * nx) xb_add(&bar[XB_TOPGEN], 1u);
            else XB_SPIN(xb_ld(&bar[XB_TOPGEN]) == tg, bar);
            __builtin_amdgcn_fence(__ATOMIC_ACQUIRE, "agent");
            xb_add(&bar[XB_XGEN(b.x)], 1u);
            asm volatile("s_waitcnt vmcnt(0)" ::: "memory");
        } else {
            XB_SPIN(xb_ld(&bar[XB_XGEN(b.x)]) == gen, bar);
            __builtin_amdgcn_fence(__ATOMIC_ACQUIRE, "agent");
            asm volatile("s_waitcnt vmcnt(0)" ::: "memory");
        }
    }
    __syncthreads();
}

#define CGSYNC() do { asm volatile("s_waitcnt vmcnt(0) lgkmcnt(0)" ::: "memory"); grid.sync(); __builtin_amdgcn_fence(__ATOMIC_ACQUIRE, "agent"); asm volatile("s_waitcnt vmcnt(0)" ::: "memory"); } while (0)
#define GSYNC() xcd_barrier(xbar)

template <int CH>
__device__ __forceinline__ void mixer_chunk(const XcdBarrier& xbar, LAS unsigned char* lds, int G, int gw, int NGW, const bf16_t* H, const bf16_t* Win, const bf16_t* Wa, const bf16_t* Wb, const bf16_t* Wout,
        bf16_t* proj, bf16_t* og, float* lse, bf16_t* oa, bf16_t* ob, bf16_t* Z, bf16_t* Dbuf, const float* rope, const float* bgate, const float* rpb) {
    int tid_ = threadIdx.x; asm volatile("" : "+v"(tid_));
    const int tid = tid_, lane = tid & 63, wid = __builtin_amdgcn_readfirstlane(tid >> 6);
    pg8::StaticOrder SO;
    const int gwx = ((G % 8 == 0) ? ((int)(blockIdx.x % 8) * (G / 8) + (int)(blockIdx.x / 8)) : (int)blockIdx.x) * NWAVES + wid;

        constexpr int ch = CH; constexpr int S = (CH == 0) ? 8192 : 16384;
        const bf16_t* Hc = H + (size_t)ch * TC * DM;
        { pg8::Gemm g{Hc, Win, TC, INW, DM}; SO.init(TC, INW, G, blockIdx.x); EpiProj E{proj, rope, bgate, S - 1, (S == 8192) ? 13 : 14}; pg8::gemm_phase(lds, g, SO, E); }
        GSYNC();
        {
            LAS unsigned char* wl = lds + wid * WAVE_LDS;
            for (int u = gwx; u < 3 * 4 * (TC / 32); u += NGW) { if (!SKIP_A) attnA_unit(u, proj, og, lse, S, wl, lane); }
        }
        GSYNC();
        {
            LAS float* rpbL = (LAS float*)(lds + RPB_OFF);
            for (int i = tid; i < 8 * 465; i += NTHR) rpbL[i] = rpb[i] * LOG2E;
            __syncthreads();
            LAS unsigned char* wl = lds + wid * WAVE_LDS;
            for (int u = gwx; u < 8 * (TC / 32); u += NGW) { if (!SKIP_B) attnB_unit(u, proj, ob, S, wl, rpbL, lane); }
            for (int i = blockIdx.x * NTHR + tid; i < TC * 32; i += G * NTHR) {
                const int tl = i >> 5, h = (i >> 3) & 3, c8 = i & 7;
                const float l0 = lse[tl * 12 + h], l1 = lse[tl * 12 + 4 + h], l2 = lse[tl * 12 + 8 + h];
                const float mx = fmaxf(l0, fmaxf(l1, l2));
                float e0 = fexp2(l0 - mx), e1 = fexp2(l1 - mx), e2 = fexp2(l2 - mx);
                const float is = frcp(e0 + e1 + e2); e0 *= is; e1 *= is; e2 *= is;
                const bf16_t* p = og + (size_t)tl * 768 + h * 64 + c8 * 8;
                const u32x4 v0 = *(const u32x4*)p, v1 = *(const u32x4*)(p + 256), v2 = *(const u32x4*)(p + 512);
                u32x4 w;
                w.x = cvt_pk_bf16(e0 * bf_lo(v0.x) + e1 * bf_lo(v1.x) + e2 * bf_lo(v2.x), e0 * bf_hi(v0.x) + e1 * bf_hi(v1.x) + e2 * bf_hi(v2.x));
                w.y = cvt_pk_bf16(e0 * bf_lo(v0.y) + e1 * bf_lo(v1.y) + e2 * bf_lo(v2.y), e0 * bf_hi(v0.y) + e1 * bf_hi(v1.y) + e2 * bf_hi(v2.y));
                w.z = cvt_pk_bf16(e0 * bf_lo(v0.z) + e1 * bf_lo(v1.z) + e2 * bf_lo(v2.z), e0 * bf_hi(v0.z) + e1 * bf_hi(v1.z) + e2 * bf_hi(v2.z));
                w.w = cvt_pk_bf16(e0 * bf_lo(v0.w) + e1 * bf_lo(v1.w) + e2 * bf_lo(v2.w), e0 * bf_hi(v0.w) + e1 * bf_hi(v1.w) + e2 * bf_hi(v2.w));
                *(u32x4*)(oa + (size_t)tl * 256 + h * 64 + c8 * 8) = w;
            }
        }
        GSYNC();
        { pg8::Gemm g{oa, Wa, TC, DM, 256}; SO.init(TC, DM, G, blockIdx.x); EpiGate<false> E{Z, proj, 0}; pg8::gemm_phase(lds, g, SO, E); }
        { pg8::Gemm g{ob, Wb, TC, DM, 512}; SO.init(TC, DM, G, blockIdx.x); EpiGate<true> E{Z, proj, DM}; pg8::gemm_phase(lds, g, SO, E); }
        GSYNC();
        { pg8::Gemm g{Z, Wout, TC, DM, DM}; SO.init(TC, DM, G, blockIdx.x); EpiPlain E{Dbuf + (size_t)ch * TC * DM, DM}; pg8::gemm_phase(lds, g, SO, E); }

}

__global__ void __launch_bounds__(NTHR, 2) enc_fwd(Args a) {
    extern __shared__ __attribute__((aligned(16))) unsigned char lds_raw[];
    LAS unsigned char* lds = (LAS unsigned char*)lds_raw;
    cg::grid_group grid = cg::this_grid();
    const int tid = threadIdx.x, lane = tid & 63, wid = __builtin_amdgcn_readfirstlane(tid >> 6);
    const int G = gridDim.x, gw = blockIdx.x * NWAVES + wid, NGW = G * NWAVES;
    unsigned char* ws = a.ws;
    const float* x_p = a.in[0]; const float* x_s = a.in[1];
    bf16_t* Wgu1 = (bf16_t*)(ws + WS_WGU1); bf16_t* Wd1 = (bf16_t*)(ws + WS_WD1); bf16_t* Win = (bf16_t*)(ws + WS_WIN);
    bf16_t* Wa = (bf16_t*)(ws + WS_WA); bf16_t* Wb = (bf16_t*)(ws + WS_WB); bf16_t* Wout = (bf16_t*)(ws + WS_WOUT);
    bf16_t* Wgu2 = (bf16_t*)(ws + WS_WGU2); bf16_t* Wd2 = (bf16_t*)(ws + WS_WD2);
    float* rope = (float*)(ws + WS_ROPE); float* lse = (float*)(ws + WS_LSE);
    bf16_t* H = (bf16_t*)(ws + WS_H); bf16_t* A1 = (bf16_t*)(ws + WS_A1); bf16_t* Dbuf = (bf16_t*)(ws + WS_D); bf16_t* XB = (bf16_t*)(ws + WS_XB);
    bf16_t* proj = (bf16_t*)(ws + WS_PROJ); bf16_t* og = (bf16_t*)(ws + WS_OG); bf16_t* oa = (bf16_t*)(ws + WS_OA); bf16_t* ob = (bf16_t*)(ws + WS_OB); bf16_t* Z = (bf16_t*)(ws + WS_Z);
    float* out = a.out;
    volatile LAS unsigned* xst = (volatile LAS unsigned*)(lds + 131072 + 15360);
    if (tid < 2) xst[tid] = 0u;
    __syncthreads();
    const XcdBarrier xbar = xcd_barrier_post((unsigned*)(ws + WS_BAR), xst);
    grid.sync();

    {
        LAS float* scr = (LAS float*)(lds + wid * 16384);
        transpose_items<1>(a.in[4], a.in[5], FF, Wgu1, DM, 2 * FF, scr, lane, gw, NGW);
        transpose_items<0>(a.in[6], nullptr, DM, Wd1, FF, DM, scr, lane, gw, NGW);
        transpose_items<2>(a.in[9], nullptr, INW, Win, DM, INW, scr, lane, gw, NGW);
        transpose_items<0>(a.in[12], nullptr, DM, Wa, 256, DM, scr, lane, gw, NGW);
        transpose_items<0>(a.in[13], nullptr, DM, Wb, 512, DM, scr, lane, gw, NGW);
        transpose_items<0>(a.in[14], nullptr, DM, Wout, DM, DM, scr, lane, gw, NGW);
        transpose_items<1>(a.in[17], a.in[18], FF, Wgu2, DM, 2 * FF, scr, lane, gw, NGW);
        transpose_items<0>(a.in[19], nullptr, DM, Wd2, FF, DM, scr, lane, gw, NGW);
        for (int i = blockIdx.x * NTHR + tid; i < 16384 * 8; i += G * NTHR) {
            const int pos = i >> 3, f = i & 7;
            const double invf = (f == 0) ? 1.0 : (f == 1) ? 0.19392274474868576 : (f == 2) ? 0.03760603093086393 : (f == 3) ? 0.007292664737217109 : (f == 4) ? 0.001414213562373095
                              : (f == 5) ? 0.0002742481756762073 : (f == 6) ? 5.318295896944988e-05 : 1.031338537721246e-05;
            const float angf = (float)pos * (float)invf;
            double tt = (double)angf * 0.15915494309189535; tt -= floor(tt);
            const float fr = (float)tt;
            rope[pos * 16 + f] = __builtin_amdgcn_cosf(fr); rope[pos * 16 + 8 + f] = __builtin_amdgcn_sinf(fr);
        }
        row_pass<false, true, false, false>(x_p, x_s, nullptr, nullptr, nullptr, 0.f, nullptr, nullptr, a.in[2], H, lane, gw, NGW);
    }
    GSYNC();
    pg8::StaticOrder SO;
    { pg8::Gemm g{H, Wgu1, TALL, 2 * FF, DM}; SO.init(TALL, 2 * FF, G, blockIdx.x); EpiSwiglu E{A1}; pg8::gemm_phase(lds, g, SO, E); }
    GSYNC();
    { pg8::Gemm g{A1, Wd1, TALL, DM, FF}; SO.init(TALL, DM, G, blockIdx.x); EpiPlain E{Dbuf, DM}; pg8::gemm_phase(lds, g, SO, E); }
    GSYNC();
    row_pass<true, true, false, true>(x_p, x_s, nullptr, Dbuf, a.in[3], 0.5f, nullptr, XB, a.in[7], H, lane, gw, NGW);
    GSYNC();
    if (STOP_AFTER <= 1) return;
    if (STOP_AFTER <= 1) return;
    mixer_chunk<0>(xbar, lds, G, gw, NGW, H, Win, Wa, Wb, Wout, proj, og, lse, oa, ob, Z, Dbuf, rope, a.in[10], a.in[11]);
    mixer_chunk<1>(xbar, lds, G, gw, NGW, H, Win, Wa, Wb, Wout, proj, og, lse, oa, ob, Z, Dbuf, rope, a.in[10], a.in[11]);
    mixer_chunk<2>(xbar, lds, G, gw, NGW, H, Win, Wa, Wb, Wout, proj, og, lse, oa, ob, Z, Dbuf, rope, a.in[10], a.in[11]);
    GSYNC();
    row_pass<true, true, true, true>(nullptr, nullptr, XB, Dbuf, a.in[8], 1.0f, nullptr, XB, a.in[15], H, lane, gw, NGW);
    GSYNC();
    if (STOP_AFTER <= 2) return;
    if (STOP_AFTER <= 2) return;
    { pg8::Gemm g{H, Wgu2, TALL, 2 * FF, DM}; SO.init(TALL, 2 * FF, G, blockIdx.x); EpiSwiglu E{A1}; pg8::gemm_phase(lds, g, SO, E); }
    GSYNC();
    { pg8::Gemm g{A1, Wd2, TALL, DM, FF}; SO.init(TALL, DM, G, blockIdx.x); EpiPlain E{Dbuf, DM}; pg8::gemm_phase(lds, g, SO, E); }
    GSYNC();
    row_pass<true, false, true, false>(nullptr, nullptr, XB, Dbuf, a.in[16], 0.5f, out, nullptr, nullptr, nullptr, lane, gw, NGW);
}

extern "C" void kernel_launch(void* const* d_in, const int* in_sizes, int n_in, void* d_out, int out_size, void* d_ws, size_t ws_size, hipStream_t stream) {
    static int grid = 0;
    if (grid == 0) {
        if (n_in != 20 || out_size != TALL * DM || ws_size < WS_END) { fprintf(stderr, "kernel_launch: unexpected shapes (n_in %d out %d ws %zu)\n", n_in, out_size, ws_size); grid = -1; return; }
        int dev = 0, cus = 0, per_cu = 0;
        hipGetDevice(&dev);
        hipDeviceGetAttribute(&cus, hipDeviceAttributeMultiprocessorCount, dev);
        hipFuncSetAttribute((const void*)enc_fwd, hipFuncAttributeMaxDynamicSharedMemorySize, LDS_BYTES);
        hipOccupancyMaxActiveBlocksPerMultiprocessor(&per_cu, (const void*)enc_fwd, NTHR, LDS_BYTES);
        if (per_cu < 1) per_cu = 1;
        grid = cus * per_cu;
        (void)hipGetLastError();
    }
    if (grid < 0) return;
    if (hipMemsetAsync((char*)d_ws + WS_BAR, 0, 16384, stream) != hipSuccess) { fprintf(stderr, "memset of barrier words failed\n"); return; }
    Args a{};
    for (int i = 0; i < 20; ++i) a.in[i] = (const float*)d_in[i];
    a.out = (float*)d_out; a.ws = (unsigned char*)d_ws;
    void* args[] = {&a};
    hipError_t e = hipLaunchCooperativeKernel((const void*)enc_fwd, dim3(grid), dim3(NTHR), args, LDS_BYTES, stream);
    if (e != hipSuccess) fprintf(stderr, "cooperative launch failed: %s (grid %d)\n", hipGetErrorString(e), grid);
}
```

```cpp
#include <hip/hip_runtime.h>
#include <hip/hip_cooperative_groups.h>
#include <cstdio>
#include <cstdint>
namespace cg = cooperative_groups;

#define LAS __attribute__((address_space(3)))
typedef unsigned short bf16_t;
typedef short bf16x8 __attribute__((ext_vector_type(8)));
typedef short s16x4 __attribute__((ext_vector_type(4)));
typedef float f32x4 __attribute__((ext_vector_type(4)));
typedef float f32x16 __attribute__((ext_vector_type(16)));
typedef unsigned u32x4 __attribute__((ext_vector_type(4)));
typedef unsigned u32x2 __attribute__((ext_vector_type(2)));

constexpr int DM = 1024, FF = 2816, TALL = 49152, TP = 16384, TC = 16384, NCH = 3;
constexpr int INW = 5888, GOFF = 3840;
constexpr int HSL = TC * 64;
constexpr int GPITCH = 2048;
constexpr int NWAVES = 8, NTHR = 512;
constexpr float RMS_EPS = 1e-6f;
constexpr float LOG2E = 1.4426950408889634f;
constexpr float QSCALE = 0.125f * LOG2E;
constexpr float NEGBIG = -1e30f;

constexpr size_t MiB = 1u << 20;
constexpr size_t WS_WGU1 = 0, WS_WD1 = 11 * MiB, WS_WIN = 16 * MiB + MiB / 2, WS_WA = 28 * MiB, WS_WB = 28 * MiB + MiB / 2, WS_WOUT = 29 * MiB + MiB / 2,
                 WS_WGU2 = 31 * MiB + MiB / 2, WS_WD2 = 42 * MiB + MiB / 2, WS_ROPE = 48 * MiB, WS_LSE = 49 * MiB;
constexpr size_t WS_H = 50 * MiB;
constexpr size_t WS_A1 = 146 * MiB;
constexpr size_t WS_D = WS_H;
constexpr size_t WS_XB = 410 * MiB;
constexpr size_t WS_BAR = 506 * MiB;
constexpr size_t WS_END = 507 * MiB;
constexpr size_t WS_PROJ = 146 * MiB;
constexpr size_t WS_OG = 330 * MiB;
constexpr size_t WS_OA = 354 * MiB;
constexpr size_t WS_OB = 362 * MiB;
constexpr size_t WS_Z = 378 * MiB;

#ifndef STOP_AFTER
#define STOP_AFTER 99
#endif
#ifndef SKIP_A
#define SKIP_A 0
#endif
#ifndef SKIP_B
#define SKIP_B 0
#endif
constexpr int LDS_BYTES = 131072 + 16384;

typedef float f32x2_t __attribute__((ext_vector_type(2))); typedef __bf16 bf16x2_t __attribute__((ext_vector_type(2)));
__device__ __forceinline__ unsigned cvt_pk_bf16(float lo, float hi) { f32x2_t v = {lo, hi}; bf16x2_t b = __builtin_convertvector(v, bf16x2_t); return __builtin_bit_cast(unsigned, b); }
__device__ __forceinline__ float bf_lo(unsigned u) { return __uint_as_float(u << 16); }
__device__ __forceinline__ float bf_hi(unsigned u) { return __uint_as_float(u & 0xffff0000u); }
__device__ __forceinline__ float fexp2(float x) { return __builtin_amdgcn_exp2f(x); }
__device__ __forceinline__ float frcp(float x) { return __builtin_amdgcn_rcpf(x); }
__device__ __forceinline__ float sigmoidf_(float x) { return frcp(1.0f + fexp2(-x * LOG2E)); }
__device__ __forceinline__ float wave_sum(float v) {
#pragma unroll
    for (int o = 1; o < 64; o <<= 1) v += __shfl_xor(v, o);
    return v;
}

namespace pg8 {
constexpr int BM = 256, BK = 64, HALF = 128, HTB = HALF * BK * 2, STAGE_BYTES = 8 * HTB, NXCD = 8, WGM = 4;
__host__ __device__ __forceinline__ int lds_byte(int r, int c) { const int st = (r >> 4) * 2 + (c >> 5), rr = r & 15, cc = c & 31, ob = rr * 64 + cc * 2; return st * 1024 + (ob ^ (((ob >> 9) & 1) << 5)); }
__host__ __device__ __forceinline__ void stage_rc(int b, int& R, int& C) { const int st = b / 1024, sb = b % 1024, swz = sb ^ (((sb >> 9) & 1) << 5); R = (st >> 1) * 16 + swz / 64; C = (st & 1) * 32 + (swz % 64) / 2; }
__host__ __device__ __forceinline__ int perm32(int rho) { const int n = rho >> 4, i = rho & 15; return 8 * (i >> 2) + 4 * n + (i & 3); }

struct Unit { int pm, pn; };
struct Gemm { const bf16_t* A; const bf16_t* Bt; int M, N, K; };

struct StaticOrder {
    int nM, nN, nwg, G, c;
    __device__ void init(int M, int N, int G_, int c_) { nM = M / BM; nN = N / BM; nwg = nM * nN; G = G_; c = c_; }
    __device__ bool next(int i, Unit& u) const {
        const long L = (long)i * G + c; if (L >= nwg) return false;
        int wgid = (int)L; { const int q = nwg / NXCD, r = nwg % NXCD, xcd = wgid % NXCD, off = wgid / NXCD; wgid = (xcd < r ? xcd * (q + 1) : r * (q + 1) + (xcd - r) * q) + off; }
        const int wgm = (nN <= 4) ? 8 : 4;
        const int nig = wgm * nN, gid = wgid / nig, fm = gid * wgm, gsz = (nM - fm) < wgm ? (nM - fm) : wgm;
        u.pm = fm + ((wgid % nig) % gsz); u.pn = (wgid % nig) / gsz; return true;
    }
};

template <class Epi>
__device__ __forceinline__ void gemm_phase(LAS unsigned char* lds, const Gemm g, const StaticOrder& S, const Epi& E) {
    int tid_ = threadIdx.x; asm volatile("" : "+v"(tid_));
    const int tid = tid_, wid = __builtin_amdgcn_readfirstlane(tid >> 6), lane = tid & 63, wr = wid >> 2, wc = wid & 3, fr = lane & 15, fq = lane >> 4;
    const int K = g.K, nt = K / BK;
    unsigned voffA[2], voffB[2];
#pragma unroll
    for (int i = 0; i < 2; ++i) { int R, C; stage_rc(tid * 16 + i * 8192, R, C); const int Rb = (R & ~31) + perm32(R & 31);
        voffA[i] = (unsigned)(R * K + C) * 2u; voffB[i] = (unsigned)(Rb * K + C) * 2u; }
    const size_t kstep = (size_t)(BK * 2);
    const size_t hstep = (size_t)HALF * K * 2;
    const size_t tstep = 2 * hstep;
    const unsigned ldsw = (unsigned)wid * 1024u;
    const int aoff = lds_byte(wr * 64 + fr, fq * 8), boff = lds_byte(wc * 32 + fr, fq * 8);
#define PG8_SA(b, h) (((b) * 2 + (h)) * HTB)
#define PG8_SB(b, h) ((4 + (b) * 2 + (h)) * HTB)
#define PG8_STAGE(bufoff, gbase, voff) do { _Pragma("unroll") for (int _i = 0; _i < 2; ++_i) \
        __builtin_amdgcn_global_load_lds((const __attribute__((address_space(1))) unsigned*)((const char*)(gbase) + (voff)[_i]), (LAS unsigned*)(lds + (bufoff) + ldsw + _i * 8192), 16, 0, 0); } while (0)
#define PG8_LDA(dst, b, h) do { _Pragma("unroll") for (int m = 0; m < 4; ++m) _Pragma("unroll") for (int k = 0; k < 2; ++k) dst[m][k] = *(const LAS bf16x8*)(lds + PG8_SA(b, h) + aoff + m * 2048 + k * 1024); } while (0)
#define PG8_LDB(dst, b, h) do { _Pragma("unroll") for (int n = 0; n < 2; ++n) _Pragma("unroll") for (int k = 0; k < 2; ++k) dst[n][k] = *(const LAS bf16x8*)(lds + PG8_SB(b, h) + boff + n * 2048 + k * 1024); } while (0)
#define PG8_MMA(ai, bj, At, Bt) do { __builtin_amdgcn_s_setprio(1); _Pragma("unroll") for (int m = 0; m < 4; ++m) _Pragma("unroll") for (int n = 0; n < 2; ++n) _Pragma("unroll") for (int k = 0; k < 2; ++k) \
        acc[ai][bj][m][n] = __builtin_amdgcn_mfma_f32_16x16x32_bf16(Bt[n][k], At[m][k], acc[ai][bj][m][n], 0, 0, 0); __builtin_amdgcn_s_setprio(0); } while (0)
#define PG8_WAIT_V(n) asm volatile("s_waitcnt vmcnt(" #n ")" ::: "memory")
#define PG8_WAIT_L(n) asm volatile("s_waitcnt lgkmcnt(" #n ")" ::: "memory")
#define PG8_BAR __builtin_amdgcn_s_barrier()
#define PG8_SCHED __builtin_amdgcn_sched_barrier(0)
    Unit cur, nxt; int ui = 0;
    if (!S.next(0, cur)) return;
    f32x4 acc[2][2][4][2];
#pragma unroll
    for (int a = 0; a < 2; ++a)
#pragma unroll
        for (int b = 0; b < 2; ++b)
#pragma unroll
            for (int m = 0; m < 4; ++m)
#pragma unroll
                for (int n = 0; n < 2; ++n) acc[a][b][m][n] = (f32x4){0.f, 0.f, 0.f, 0.f};
    bf16x8 At[4][2], B0[2][2], B1[2][2];
    const char* cA = (const char*)g.A + (size_t)cur.pm * tstep; const char* cB = (const char*)g.Bt + (size_t)cur.pn * tstep;
    PG8_STAGE(PG8_SB(0, 0), cB, voffB); PG8_STAGE(PG8_SB(0, 1), cB + hstep, voffB); PG8_STAGE(PG8_SA(0, 0), cA, voffA); PG8_STAGE(PG8_SA(0, 1), cA + hstep, voffA);
    if (wr == 1) PG8_BAR;
    PG8_WAIT_V(2); PG8_BAR;
    PG8_STAGE(PG8_SB(1, 0), cB + kstep, voffB); PG8_STAGE(PG8_SA(1, 0), cA + kstep, voffA); PG8_STAGE(PG8_SB(1, 1), cB + hstep + kstep, voffB);
    PG8_WAIT_V(6); PG8_BAR;
    for (;;) {
        const bool has_next = S.next(ui + 1, nxt);
        const char* nA = has_next ? (const char*)g.A + (size_t)nxt.pm * tstep : cA; const char* nB = has_next ? (const char*)g.Bt + (size_t)nxt.pn * tstep : cB;
#pragma nounroll
        for (int t = 0; t < nt; t += 2) {
            const bool last = (t == nt - 2);
            const char* a1 = cA + (size_t)(t + 1) * kstep;
            const char* a2 = last ? nA : cA + (size_t)(t + 2) * kstep; const char* b2 = last ? nB : cB + (size_t)(t + 2) * kstep;
            const char* a3 = a2 + kstep; const char* b3 = b2 + kstep;
            PG8_LDB(B0, 0, 0); PG8_LDB(B1, 0, 1); PG8_SCHED; PG8_LDA(At, 0, 0); PG8_STAGE(PG8_SA(1, 1), a1 + hstep, voffA);
            PG8_WAIT_V(8); PG8_WAIT_L(0); PG8_BAR; PG8_MMA(0, 0, At, B0); PG8_MMA(0, 1, At, B1); PG8_BAR; PG8_SCHED;
            PG8_LDA(At, 0, 1); PG8_STAGE(PG8_SB(0, 0), b2, voffB); PG8_STAGE(PG8_SB(0, 1), b2 + hstep, voffB); PG8_STAGE(PG8_SA(0, 0), a2, voffA);
            PG8_WAIT_V(8); PG8_WAIT_L(0); PG8_BAR; PG8_MMA(1, 0, At, B0); PG8_MMA(1, 1, At, B1); PG8_BAR; PG8_SCHED;
            PG8_LDB(B0, 1, 0); PG8_LDB(B1, 1, 1); PG8_SCHED; PG8_LDA(At, 1, 0); PG8_STAGE(PG8_SA(0, 1), a2 + hstep, voffA);
            PG8_WAIT_V(8); PG8_WAIT_L(0); PG8_BAR; PG8_MMA(0, 0, At, B0); PG8_MMA(0, 1, At, B1); PG8_BAR; PG8_SCHED;
            PG8_LDA(At, 1, 1); PG8_STAGE(PG8_SB(1, 0), b3, voffB); PG8_STAGE(PG8_SB(1, 1), b3 + hstep, voffB); PG8_STAGE(PG8_SA(1, 0), a3, voffA);
            PG8_WAIT_V(8); PG8_WAIT_L(0); PG8_BAR; PG8_MMA(1, 0, At, B0); PG8_MMA(1, 1, At, B1); PG8_BAR; PG8_SCHED;
        }
        if (wr == 0) PG8_BAR;
        E(acc, cur, wr, wc, fr, fq);
        if (!has_next) break;
#pragma unroll
        for (int a = 0; a < 2; ++a)
#pragma unroll
            for (int b = 0; b < 2; ++b)
#pragma unroll
                for (int m = 0; m < 4; ++m)
#pragma unroll
                    for (int n = 0; n < 2; ++n) acc[a][b][m][n] = (f32x4){0.f, 0.f, 0.f, 0.f};
        cur = nxt; cA = nA; cB = nB; ++ui;
        if (wr == 1) PG8_BAR;
    }
    PG8_WAIT_V(0);
    PG8_BAR;
#undef PG8_SA
#undef PG8_SB
#undef PG8_STAGE
#undef PG8_LDA
#undef PG8_LDB
#undef PG8_MMA
#undef PG8_WAIT_V
#undef PG8_WAIT_L
#undef PG8_BAR
#undef PG8_SCHED
}
}
using pg8::Unit;

typedef f32x4 AccT[2][2][4][2];

#define OPAQUE(o) asm volatile("" : "+v"(o))
struct EpiPlain {
    bf16_t* O; int ldc;
    __device__ __forceinline__ void operator()(const AccT& acc, const Unit& u, int wr, int wc, int fr, int fq) const {
        const unsigned lo = (unsigned)((u.pm * 256 + wr * 64 + fr) * ldc + u.pn * 256 + wc * 32 + 8 * fq) * 2u;
#pragma unroll
        for (int ai = 0; ai < 2; ++ai)
#pragma unroll
            for (int m = 0; m < 4; ++m) { unsigned o = lo + (unsigned)((ai * 128 + m * 16) * ldc) * 2u; OPAQUE(o); char* rowp = (char*)O + o;
#pragma unroll
                for (int bj = 0; bj < 2; ++bj) { const f32x4 v0 = acc[ai][bj][m][0], v1 = acc[ai][bj][m][1];
                    u32x4 w; w.x = cvt_pk_bf16(v0[0], v0[1]); w.y = cvt_pk_bf16(v0[2], v0[3]); w.z = cvt_pk_bf16(v1[0], v1[1]); w.w = cvt_pk_bf16(v1[2], v1[3]);
                    *(u32x4*)(rowp + bj * 256) = w; } }
    }
};
struct EpiSwiglu {
    bf16_t* O;
    __device__ __forceinline__ void operator()(const AccT& acc, const Unit& u, int wr, int wc, int fr, int fq) const {
        const unsigned lo = (unsigned)((u.pm * 256 + wr * 64 + fr) * FF + u.pn * 128 + wc * 32 + 8 * fq) * 2u;
#pragma unroll
        for (int ai = 0; ai < 2; ++ai)
#pragma unroll
            for (int m = 0; m < 4; ++m) { unsigned o = lo + (unsigned)((ai * 128 + m * 16) * FF) * 2u; OPAQUE(o); char* rowp = (char*)O + o;
                float r[8];
#pragma unroll
                for (int n = 0; n < 2; ++n)
#pragma unroll
                    for (int j = 0; j < 4; ++j) { const float gt = acc[ai][0][m][n][j], up = acc[ai][1][m][n][j]; r[n * 4 + j] = gt * sigmoidf_(gt) * up; }
                u32x4 w; w.x = cvt_pk_bf16(r[0], r[1]); w.y = cvt_pk_bf16(r[2], r[3]); w.z = cvt_pk_bf16(r[4], r[5]); w.w = cvt_pk_bf16(r[6], r[7]);
                *(u32x4*)rowp = w; }
    }
};
struct EpiProj {
    bf16_t* O; const float* rope; const float* bgate; int posmask; int lgS;
    __device__ __forceinline__ void operator()(const AccT& acc, const Unit& u, int wr, int wc, int fr, int fq) const {
        const int pn = u.pn;
        const int row0 = u.pm * 256 + wr * 64 + fr, col0 = pn * 256 + wc * 32 + 8 * fq;
        const bool ropeTile = pn < 6, gateTile = pn >= 15;
        const float sc = (pn < 3 || pn == 9 || pn == 10) ? QSCALE : 1.0f;
        const bool rot = ropeTile && ((wc & 1) == 0) && (fq < 2);
        if (gateTile) {
            const unsigned lo = (unsigned)(3840 * TC + row0 * GPITCH + (col0 - GOFF)) * 2u;
#pragma unroll
            for (int bj = 0; bj < 2; ++bj) { const f32x4 b0 = *(const f32x4*)(bgate + col0 - GOFF + bj * 128), b1 = *(const f32x4*)(bgate + col0 - GOFF + bj * 128 + 4);
#pragma unroll
                for (int ai = 0; ai < 2; ++ai)
#pragma unroll
                    for (int m = 0; m < 4; ++m) { unsigned o = lo + (unsigned)((ai * 128 + m * 16) * GPITCH) * 2u + bj * 256; OPAQUE(o);
                        f32x4 v0 = acc[ai][bj][m][0] + b0, v1 = acc[ai][bj][m][1] + b1;
#pragma unroll
                        for (int j = 0; j < 4; ++j) { v0[j] = sigmoidf_(v0[j]); v1[j] = sigmoidf_(v1[j]); }
                        u32x4 w; w.x = cvt_pk_bf16(v0[0], v0[1]); w.y = cvt_pk_bf16(v0[2], v0[3]); w.z = cvt_pk_bf16(v1[0], v1[1]); w.w = cvt_pk_bf16(v1[2], v1[3]);
                        *(u32x4*)((char*)O + o) = w; } }
        } else {
            const int dsh = (pn < 9) ? 2 * (pn % 3) : 0;
            const int hs0 = pn * 4 + (wc >> 1);
            const unsigned hoff = (unsigned)(hs0 * HSL + 32 * (wc & 1) + 8 * fq) * 2u;
#pragma unroll
            for (int ai = 0; ai < 2; ++ai) {
                f32x4 csv[4], snv[4];
#pragma unroll
                for (int m = 0; m < 4; ++m) { csv[m] = (f32x4){1.f, 1.f, 1.f, 1.f}; snv[m] = (f32x4){0.f, 0.f, 0.f, 0.f}; }
                if (ropeTile) {
#pragma unroll
                    for (int m = 0; m < 4; ++m) { unsigned ro = (unsigned)(((row0 + ai * 128 + m * 16) & posmask) * 16 + 4 * (fq & 1)) * 4u; OPAQUE(ro);
                        const f32x4 c = *(const f32x4*)((const char*)rope + ro), s = *(const f32x4*)((const char*)rope + ro + 32);
                        csv[m] = rot ? c : csv[m]; snv[m] = rot ? s : snv[m]; }
                }
#pragma unroll
                for (int m = 0; m < 4; ++m) { const int row = row0 + ai * 128 + m * 16, t = row & posmask;
                    const int pos = (row - t) + ((t & ((1 << dsh) - 1)) << (lgS - dsh)) + (t >> dsh);
                    unsigned o = hoff + (unsigned)pos * 128u; OPAQUE(o);
                    const f32x4 cs = csv[m], sn = snv[m];
#pragma unroll
                    for (int bj = 0; bj < 2; ++bj) { f32x4 v0 = acc[ai][bj][m][0], v1 = acc[ai][bj][m][1];
                        if (ropeTile) { const f32x4 x1 = v0, x2 = v1; v0 = x1 * cs - x2 * sn; v1 = x2 * cs + x1 * sn; }
                        v0 = v0 * sc; v1 = v1 * sc;
                        u32x4 w; w.x = cvt_pk_bf16(v0[0], v0[1]); w.y = cvt_pk_bf16(v0[2], v0[3]); w.z = cvt_pk_bf16(v1[0], v1[1]); w.w = cvt_pk_bf16(v1[2], v1[3]);
                        *(u32x4*)((char*)O + o + (unsigned)(bj * 2 * HSL) * 2u) = w; }
                    asm volatile("" ::: "memory"); }
            }
        }
    }
};
template <bool ADD> struct EpiGate {
    bf16_t* Z; const bf16_t* P; int goff;
    __device__ __forceinline__ void operator()(const AccT& acc, const Unit& u, int wr, int wc, int fr, int fq) const {
        constexpr int RB = ADD ? 2 : 4;
        const int row0 = u.pm * 256 + wr * 64 + fr, col0 = u.pn * 256 + wc * 32 + 8 * fq;
        const unsigned zl = (unsigned)(row0 * DM + col0) * 2u, gl = (unsigned)(3840 * TC + row0 * GPITCH + goff + col0) * 2u;
#pragma unroll
        for (int ai = 0; ai < 2; ++ai)
#pragma unroll
            for (int mb = 0; mb < 4; mb += RB) {
                u32x4 gw[RB][2], zo[RB][2]; unsigned zoff[RB];
#pragma unroll
                for (int k = 0; k < RB; ++k) { const int m = mb + k;
                    unsigned zo_ = zl + (unsigned)((ai * 128 + m * 16) * DM) * 2u, go_ = gl + (unsigned)((ai * 128 + m * 16) * GPITCH) * 2u; OPAQUE(zo_); OPAQUE(go_);
                    zoff[k] = zo_;
#pragma unroll
                    for (int bj = 0; bj < 2; ++bj) { gw[k][bj] = *(const u32x4*)((const char*)P + go_ + bj * 256); if (ADD) zo[k][bj] = *(const u32x4*)((const char*)Z + zo_ + bj * 256); } }
#pragma unroll
                for (int k = 0; k < RB; ++k) { const int m = mb + k;
#pragma unroll
                    for (int bj = 0; bj < 2; ++bj) { const f32x4 v0 = acc[ai][bj][m][0], v1 = acc[ai][bj][m][1]; const u32x4 g = gw[k][bj];
                        float r[8];
                        r[0] = bf_lo(g.x) * v0[0]; r[1] = bf_hi(g.x) * v0[1]; r[2] = bf_lo(g.y) * v0[2]; r[3] = bf_hi(g.y) * v0[3];
                        r[4] = bf_lo(g.z) * v1[0]; r[5] = bf_hi(g.z) * v1[1]; r[6] = bf_lo(g.w) * v1[2]; r[7] = bf_hi(g.w) * v1[3];
                        if (ADD) { const u32x4 z = zo[k][bj];
                            r[0] += bf_lo(z.x); r[1] += bf_hi(z.x); r[2] += bf_lo(z.y); r[3] += bf_hi(z.y); r[4] += bf_lo(z.z); r[5] += bf_hi(z.z); r[6] += bf_lo(z.w); r[7] += bf_hi(z.w); }
                        u32x4 w; w.x = cvt_pk_bf16(r[0], r[1]); w.y = cvt_pk_bf16(r[2], r[3]); w.z = cvt_pk_bf16(r[4], r[5]); w.w = cvt_pk_bf16(r[6], r[7]);
                        *(u32x4*)((char*)Z + zoff[k] + bj * 256) = w; } }
                asm volatile("" ::: "memory"); }
    }
};

struct Args {
    const float* in[20];
    float* out;
    unsigned char* ws;
};

__device__ __forceinline__ void transpose_item(const float* W, int ldw, int sc, bf16_t* WT, int K, int n0, int k0, LAS float* scr, int lane) {
    float tv[32];
#pragma unroll
    for (int i = 0; i < 32; ++i) tv[i] = W[(size_t)(k0 + 2 * i + (lane >> 5)) * ldw + sc];
#pragma unroll
    for (int i = 0; i < 32; ++i) scr[(2 * i + (lane >> 5)) * 33 + (lane & 31)] = tv[i];
    asm volatile("s_waitcnt lgkmcnt(0)" ::: "memory");
    const int c = lane & 7;
#pragma unroll
    for (int j = 0; j < 4; ++j) { const int n = (lane >> 3) + 8 * j; const LAS float* s = scr + (8 * c) * 33 + n;
        u32x4 o; o.x = cvt_pk_bf16(s[0 * 33], s[1 * 33]); o.y = cvt_pk_bf16(s[2 * 33], s[3 * 33]); o.z = cvt_pk_bf16(s[4 * 33], s[5 * 33]); o.w = cvt_pk_bf16(s[6 * 33], s[7 * 33]);
        *(u32x4*)(WT + (size_t)(n0 + n) * K + k0 + 8 * c) = o; }
    asm volatile("s_waitcnt lgkmcnt(0)" ::: "memory");
}
template <int KIND>
__device__ __forceinline__ void transpose_items(const float* W0, const float* W1, int ldw, bf16_t* WT, int K, int N, LAS float* scr, int lane, int gw, int NGW) {
    const int nblk = N / 32, nitems = (K / 64) * nblk;
    for (int it = gw; it < nitems; it += NGW) {
        const int kb = it / nblk, nb = it % nblk, n0 = nb * 32, n = n0 + (lane & 31);
        const float* W = W0; int sc = n;
        if (KIND == 1) { const int tile = n >> 8, bj = (n >> 7) & 1, j = n & 127; W = bj ? W1 : W0; sc = tile * 128 + j; }
        if (KIND == 2) { if (n < 1536 && (n & 63) < 16) { const int p = n & 15; const int d = (p < 8) ? ((p & 3) + ((p >> 2) << 3)) : (4 + (p & 3) + (((p - 8) >> 2) << 3)); sc = (n & ~15) + d; } }
        transpose_item(W, ldw, sc, WT, K, n0, kb * 64, scr, lane);
    }
}

template <bool HAS_D, bool HAS_H, bool XIN16, bool XOUT16>
__device__ __forceinline__ void row_pass(const float* xa, const float* xb, const bf16_t* x16in, const bf16_t* D, const float* gpost, float dscale, float* xout, bf16_t* x16out, const float* gpre, bf16_t* hout, int lane, int gw, int NGW) {
    f32x4 gp[4], gq[4];
#pragma unroll
    for (int j = 0; j < 4; ++j) { if (HAS_D) gp[j] = *(const f32x4*)(gpost + 4 * lane + 256 * j); if (HAS_H) gq[j] = *(const f32x4*)(gpre + 4 * lane + 256 * j); }
    for (int row = gw; row < TALL; row += NGW) {
        f32x4 v[4];
        if (XIN16) {
#pragma unroll
            for (int j = 0; j < 4; ++j) { const u32x2 w = *(const u32x2*)(x16in + (size_t)row * DM + 4 * lane + 256 * j); v[j] = (f32x4){bf_lo(w.x), bf_hi(w.x), bf_lo(w.y), bf_hi(w.y)}; }
        } else {
            const float* xr = (row < TP) ? xa + (size_t)row * DM : xb + (size_t)(row - TP) * DM;
#pragma unroll
            for (int j = 0; j < 4; ++j) v[j] = *(const f32x4*)(xr + 4 * lane + 256 * j);
        }
        if (HAS_D) {
            f32x4 d[4]; float ss = 0.f;
#pragma unroll
            for (int j = 0; j < 4; ++j) { const u32x2 w = *(const u32x2*)(D + (size_t)row * DM + 4 * lane + 256 * j);
                d[j] = (f32x4){bf_lo(w.x), bf_hi(w.x), bf_lo(w.y), bf_hi(w.y)}; ss += (d[j][0] * d[j][0] + d[j][1] * d[j][1]) + (d[j][2] * d[j][2] + d[j][3] * d[j][3]); }
            const float r = dscale * __builtin_amdgcn_rsqf(wave_sum(ss) * (1.0f / DM) + RMS_EPS);
#pragma unroll
            for (int j = 0; j < 4; ++j) { v[j] = v[j] + d[j] * gp[j] * r;
                if (XOUT16) { u32x2 w; w.x = cvt_pk_bf16(v[j][0], v[j][1]); w.y = cvt_pk_bf16(v[j][2], v[j][3]); *(u32x2*)(x16out + (size_t)row * DM + 4 * lane + 256 * j) = w; }
                else *(f32x4*)(xout + (size_t)row * DM + 4 * lane + 256 * j) = v[j]; }
        }
        if (HAS_H) {
            float ss = 0.f;
#pragma unroll
            for (int j = 0; j < 4; ++j) ss += (v[j][0] * v[j][0] + v[j][1] * v[j][1]) + (v[j][2] * v[j][2] + v[j][3] * v[j][3]);
            const float r = __builtin_amdgcn_rsqf(wave_sum(ss) * (1.0f / DM) + RMS_EPS);
#pragma unroll
            for (int j = 0; j < 4; ++j) { const f32x4 o = v[j] * gq[j] * r; u32x2 w; w.x = cvt_pk_bf16(o[0], o[1]); w.y = cvt_pk_bf16(o[2], o[3]);
                *(u32x2*)(hout + (size_t)row * DM + 4 * lane + 256 * j) = w; }
        }
    }
}

constexpr int WAVE_LDS = 16384;
constexpr int RPB_OFF = 131072;
__device__ __forceinline__ int crow(int r, int hi) { return (r & 3) + 8 * (r >> 2) + 4 * hi; }
__device__ __forceinline__ s16x4 vtr(LAS const unsigned char* p) { return __builtin_bit_cast(s16x4, __builtin_amdgcn_ds_read_tr16_b64_v4i16((LAS s16x4*)p)); }

struct KVRegs { u32x4 k[4], v[4]; };
#define F16Z (f32x16){0.f,0.f,0.f,0.f,0.f,0.f,0.f,0.f,0.f,0.f,0.f,0.f,0.f,0.f,0.f,0.f}

#define ATT_LOAD(R, posexpr) do { _Pragma("unroll") for (int _i = 0; _i < 4; ++_i) { const int _rowi = (lane >> 3) + 8 * _i; const size_t _off = (size_t)(posexpr) * 64 + 8 * (lane & 7); \
        R.k[_i] = *(const u32x4*)(kbase + _off); R.v[_i] = *(const u32x4*)(vbase + _off); } } while (0)
#define ATT_STORE(R, slot) do { _Pragma("unroll") for (int _i = 0; _i < 4; ++_i) { \
        *(LAS u32x4*)(wl + (slot) * 8192 + wst + _i * 1024) = R.k[_i]; *(LAS u32x4*)(wl + (slot) * 8192 + 4096 + wst + _i * 1024) = R.v[_i]; } } while (0)
#define ATT_QK(s, slot) do { s = F16Z; _Pragma("unroll") for (int _d = 0; _d < 4; ++_d) { \
        const bf16x8 _kf = *(const LAS bf16x8*)(wl + (slot) * 8192 + q32 * 128 + ((kx ^ (2 * _d)) << 4)); s = __builtin_amdgcn_mfma_f32_32x32x16_bf16(_kf, qr[_d], s, 0, 0, 0); } } while (0)
#define ATT_PACK(p0, p1, s) do { u32x4 _a, _b; _a.x = cvt_pk_bf16(s[0], s[1]); _a.y = cvt_pk_bf16(s[2], s[3]); _a.z = cvt_pk_bf16(s[4], s[5]); _a.w = cvt_pk_bf16(s[6], s[7]); \
        _b.x = cvt_pk_bf16(s[8], s[9]); _b.y = cvt_pk_bf16(s[10], s[11]); _b.z = cvt_pk_bf16(s[12], s[13]); _b.w = cvt_pk_bf16(s[14], s[15]); \
        p0 = __builtin_bit_cast(bf16x8, _a); p1 = __builtin_bit_cast(bf16x8, _b); } while (0)
#define ATT_PV(slot, p0, p1) do { LAS const unsigned char* _v0 = wl + (slot) * 8192 + 4096 + vb0; LAS const unsigned char* _v1 = wl + (slot) * 8192 + 4096 + (vb0 ^ 64); \
        { const s16x4 a = vtr(_v0), b = vtr(_v0 + 1024); const bf16x8 vf = (bf16x8){a[0], a[1], a[2], a[3], b[0], b[1], b[2], b[3]}; oT0 = __builtin_amdgcn_mfma_f32_32x32x16_bf16(vf, p0, oT0, 0, 0, 0); } \
        { const s16x4 a = vtr(_v1), b = vtr(_v1 + 1024); const bf16x8 vf = (bf16x8){a[0], a[1], a[2], a[3], b[0], b[1], b[2], b[3]}; oT1 = __builtin_amdgcn_mfma_f32_32x32x16_bf16(vf, p0, oT1, 0, 0, 0); } \
        { const s16x4 a = vtr(_v0 + 2048), b = vtr(_v0 + 3072); const bf16x8 vf = (bf16x8){a[0], a[1], a[2], a[3], b[0], b[1], b[2], b[3]}; oT0 = __builtin_amdgcn_mfma_f32_32x32x16_bf16(vf, p1, oT0, 0, 0, 0); } \
        { const s16x4 a = vtr(_v1 + 2048), b = vtr(_v1 + 3072); const bf16x8 vf = (bf16x8){a[0], a[1], a[2], a[3], b[0], b[1], b[2], b[3]}; oT1 = __builtin_amdgcn_mfma_f32_32x32x16_bf16(vf, p1, oT1, 0, 0, 0); } } while (0)
#define ATT_SOFTMAX_PV(NT, sA, sB) do { \
        float _tm = sA[0]; _Pragma("unroll") for (int _r = 1; _r < 16; ++_r) _tm = fmaxf(_tm, sA[_r]); \
        if (NT == 2) { _Pragma("unroll") for (int _r = 0; _r < 16; ++_r) _tm = fmaxf(_tm, sB[_r]); } \
        _tm = fmaxf(_tm, __shfl_xor(_tm, 32)); \
        if (__any(_tm > m_run)) { const float _mn = fmaxf(m_run, _tm), _al = fexp2(m_run - _mn); m_run = _mn; l_run *= _al; \
            _Pragma("unroll") for (int _r = 0; _r < 16; ++_r) { oT0[_r] *= _al; oT1[_r] *= _al; } } \
        float _sum = 0.f, _sum2 = 0.f; _Pragma("unroll") for (int _r = 0; _r < 16; ++_r) { sA[_r] = fexp2(sA[_r] - m_run); _sum += sA[_r]; } \
        if (NT == 2) { _Pragma("unroll") for (int _r = 0; _r < 16; ++_r) { sB[_r] = fexp2(sB[_r] - m_run); _sum2 += sB[_r]; } } \
        l_run += _sum + _sum2; \
        bf16x8 _pa0, _pa1; ATT_PACK(_pa0, _pa1, sA); ATT_PV(0, _pa0, _pa1); \
        if (NT == 2) { bf16x8 _pb0, _pb1; ATT_PACK(_pb0, _pb1, sB); ATT_PV(1, _pb0, _pb1); } \
    } while (0)
#define ATT_WRITE_O(orow) do { \
        _Pragma("unroll") for (int _g = 0; _g < 4; ++_g) { \
            u32x2 w0, w1; w0.x = cvt_pk_bf16(oT0[4 * _g] * inv, oT0[4 * _g + 1] * inv); w0.y = cvt_pk_bf16(oT0[4 * _g + 2] * inv, oT0[4 * _g + 3] * inv); \
            w1.x = cvt_pk_bf16(oT1[4 * _g] * inv, oT1[4 * _g + 1] * inv); w1.y = cvt_pk_bf16(oT1[4 * _g + 2] * inv, oT1[4 * _g + 3] * inv); \
            *(u32x2*)((orow) + 8 * _g + 4 * hi) = w0; *(u32x2*)((orow) + 32 + 8 * _g + 4 * hi) = w1; } } while (0)
#define ATT_LANE_SETUP() \
    const int q32 = lane & 31, hi = lane >> 5; \
    const int wst = (lane >> 3) * 128 + (((lane & 7) ^ ((lane >> 3) & 7)) << 4);                         \
    const int kx = hi ^ (q32 & 7);                                                                        \
    const int vb0 = (4 * hi + ((lane & 15) >> 2)) * 128 + (((2 * ((lane >> 4) & 1) + ((lane & 3) >> 1)) ^ ((4 * hi + ((lane & 15) >> 2)) & 7)) << 4) + 8 * (lane & 1);

__device__ __forceinline__ void attnA_unit(int u, const bf16_t* proj, bf16_t* og, float* lse, int S, LAS unsigned char* wl, int lane) {
    ATT_LANE_SETUP()
    const int g = u / 2048, rem = u % 2048, h = rem / 512, idx = rem % 512;
    const int per_seq = S / 32, seq = idx / per_seq, ii = idx % per_seq;
    const int dsh = 2 * g, dl = 1 << dsh;
    const int r = ii & (dl - 1), c = ii >> dsh, L = S >> dsh;
    const int hd = 4 * g + h;
    const bf16_t* kbase = proj + (size_t)(12 + hd) * HSL; const bf16_t* vbase = proj + (size_t)(24 + hd) * HSL;
    const size_t seqbase = (size_t)seq * S;
    const size_t pbase = seqbase + (size_t)r * L;
    const int qm = 32 * c + q32;
    const size_t qtok = seqbase + (size_t)qm * dl + r;
    bf16x8 qr[4];
#pragma unroll
    for (int d = 0; d < 4; ++d) qr[d] = *(const bf16x8*)(proj + (size_t)hd * HSL + (pbase + qm) * 64 + 16 * d + 8 * hi);
    const int m0 = 32 * c - 64;
    float m_run = -1e29f, l_run = 0.f;
    f32x16 oT0 = F16Z, oT1 = F16Z;
    KVRegs Ra, Rb;
#define TOKA(t) (pbase + (size_t)min(max(m0 + 32 * (t) + _rowi, 0), L - 1))
#define A_MASK(s, t) do { const int kb0 = m0 + 32 * (t); \
        if (kb0 < 0 || kb0 + 32 > L) { \
            _Pragma("unroll") for (int rr = 0; rr < 16; ++rr) { const int km = kb0 + crow(rr, hi); const int dk = km - qm; \
                const bool ok = (km >= 0) && (km < L) && (dk <= 64) && (dk >= -64); s[rr] = ok ? s[rr] : NEGBIG; } \
        } else if ((t) == 0) { \
            _Pragma("unroll") for (int rr = 0; rr < 16; ++rr) s[rr] = (crow(rr, hi) >= q32) ? s[rr] : NEGBIG; \
        } else if ((t) == 4) { \
            _Pragma("unroll") for (int rr = 0; rr < 16; ++rr) s[rr] = (crow(rr, hi) <= q32) ? s[rr] : NEGBIG; \
        } } while (0)
    ATT_LOAD(Ra, TOKA(0)); ATT_LOAD(Rb, TOKA(1));
    ATT_STORE(Ra, 0); ATT_STORE(Rb, 1); ATT_LOAD(Ra, TOKA(2)); ATT_LOAD(Rb, TOKA(3));
    { f32x16 s0, s1; ATT_QK(s0, 0); ATT_QK(s1, 1); A_MASK(s0, 0); A_MASK(s1, 1); ATT_SOFTMAX_PV(2, s0, s1); }
    ATT_STORE(Ra, 0); ATT_STORE(Rb, 1); ATT_LOAD(Ra, TOKA(4));
    { f32x16 s0, s1; ATT_QK(s0, 0); ATT_QK(s1, 1); A_MASK(s0, 2); A_MASK(s1, 3); ATT_SOFTMAX_PV(2, s0, s1); }
    ATT_STORE(Ra, 0);
    { f32x16 s0; ATT_QK(s0, 0); A_MASK(s0, 4); ATT_SOFTMAX_PV(1, s0, s0); }
#undef A_MASK
#undef TOKA
    const float lt = l_run + __shfl_xor(l_run, 32);
    const float inv = frcp(lt);
    bf16_t* orow = og + qtok * 768 + hd * 64;
    ATT_WRITE_O(orow);
    if (hi == 0) lse[qtok * 12 + hd] = m_run + __builtin_amdgcn_logf(lt);
}

__device__ __forceinline__ void attnB_unit(int u, const bf16_t* proj, bf16_t* ob, int S, LAS unsigned char* wl, LAS const float* rpbL, int lane) {
    ATT_LANE_SETUP()
    const int h = u / 512, idx = u % 512;
    const int per_seq = S / 32, seq = idx / per_seq, ii = idx % per_seq;
    const int rp = ii >> 2, cc = ii & 3, rows = S / 64;
    const int ri0 = 2 * rp, qrow = ri0 + (q32 >> 4), qcolg = 16 * cc + (q32 & 15);
    const bf16_t* kbase = proj + (size_t)(44 + h) * HSL; const bf16_t* vbase = proj + (size_t)(52 + h) * HSL;
    const size_t seqbase = (size_t)seq * S;
    const size_t qtok = seqbase + (size_t)qrow * 64 + qcolg;
    bf16x8 qr[4];
#pragma unroll
    for (int d = 0; d < 4; ++d) qr[d] = *(const bf16x8*)(proj + (size_t)(36 + h) * HSL + qtok * 64 + 16 * d + 8 * hi);
    const int w0 = (cc == 0) ? 0 : (cc == 1) ? 8 : (cc == 2) ? 24 : 32;
    const int rs0 = min(max(ri0 - 4, 0), rows - 8), rs1 = min(max(ri0 - 3, 0), rows - 8);
    const int ntile = rs1 + 8 - rs0;
    const int rsq = min(max(qrow - 4, 0), rows - 8), csq = min(max(qcolg - 8, 0), 48);
    LAS const float* rb = rpbL + h * 465;
    const unsigned vmaskh = (0xFFFFu << (csq - w0)) >> (4 * hi);
    float m_run = -1e29f, l_run = 0.f;
    f32x16 oT0 = F16Z, oT1 = F16Z;
    KVRegs Ra, Rb;
#define TOKB(t) (seqbase + (size_t)(rs0 + (t)) * 64 + w0 + _rowi)
#define B_MASK(s, t) do { const int kr = rs0 + (t); const bool rowok = (kr >= rsq) && (kr < rsq + 8); \
        LAS const float* rbt = rb + ((kr - qrow + 7) * 31 + (w0 - qcolg + 15) + 4 * hi); \
        const unsigned mh = rowok ? vmaskh : 0u; float bv[16]; \
        _Pragma("unroll") for (int rr = 0; rr < 16; ++rr) bv[rr] = rbt[(rr & 3) + 8 * (rr >> 2)]; \
        _Pragma("unroll") for (int rr = 0; rr < 16; ++rr) { const int ko = (rr & 3) + 8 * (rr >> 2); const float sb = s[rr] + bv[rr]; s[rr] = (mh & (1u << ko)) ? sb : NEGBIG; } } while (0)
#define B_PAIR(t) do { f32x16 s0, s1; ATT_QK(s0, 0); ATT_QK(s1, 1); B_MASK(s0, (t)); B_MASK(s1, (t) + 1); ATT_SOFTMAX_PV(2, s0, s1); } while (0)
    ATT_LOAD(Ra, TOKB(0)); ATT_LOAD(Rb, TOKB(1));
    ATT_STORE(Ra, 0); ATT_STORE(Rb, 1); ATT_LOAD(Ra, TOKB(2)); ATT_LOAD(Rb, TOKB(3)); B_PAIR(0);
    ATT_STORE(Ra, 0); ATT_STORE(Rb, 1); ATT_LOAD(Ra, TOKB(4)); ATT_LOAD(Rb, TOKB(5)); B_PAIR(2);
    ATT_STORE(Ra, 0); ATT_STORE(Rb, 1); ATT_LOAD(Ra, TOKB(6)); ATT_LOAD(Rb, TOKB(7)); B_PAIR(4);
    ATT_STORE(Ra, 0); ATT_STORE(Rb, 1); if (ntile > 8) { ATT_LOAD(Ra, TOKB(8)); } B_PAIR(6);
    if (ntile > 8) { ATT_STORE(Ra, 0); f32x16 s0; ATT_QK(s0, 0); B_MASK(s0, 8); ATT_SOFTMAX_PV(1, s0, s0); }
#undef B_PAIR
#undef B_MASK
#undef TOKB
    const float lt = l_run + __shfl_xor(l_run, 32);
    const float inv = frcp(lt);
    bf16_t* orow = ob + qtok * 512 + h * 64;
    ATT_WRITE_O(orow);
}

#define XB_TMO      128
#define XB_XCNT(j)  (256  + 64 * (j))
#define XB_XSUB(j)  (1280 + 64 * (j))
#define XB_XGEN(j)  (2304 + 64 * (j))
#define XB_TOP      3328
#define XB_TOPGEN   3392
#define XCD_BAR_WORDS 3456
#define XB_SPIN_CAP (1u << 18)
__device__ __forceinline__ unsigned xb_ld(unsigned* p)              { return __hip_atomic_load(p, __ATOMIC_RELAXED, __HIP_MEMORY_SCOPE_AGENT); }
__device__ __forceinline__ unsigned xb_add(unsigned* p, unsigned v) { return __hip_atomic_fetch_add(p, v, __ATOMIC_RELAXED, __HIP_MEMORY_SCOPE_AGENT); }
__device__ __forceinline__ unsigned xb_xcc_id() { return (unsigned)__builtin_amdgcn_s_getreg((3 << 11) | 20) & 0xFu; }
#define XB_SPIN(cond, bar) do { unsigned _sp = 0; while (cond) { __builtin_amdgcn_s_sleep(1); \
    if ((++_sp & 255u) == 0u) { if (xb_ld(&(bar)[XB_TMO])) break; if (_sp > XB_SPIN_CAP) { atomicAdd(&(bar)[XB_TMO], 1u); break; } } } } while (0)
struct XcdBarrier { unsigned* bar; unsigned x; volatile LAS unsigned* st; };
__device__ __forceinline__ XcdBarrier xcd_barrier_post(unsigned* bar, volatile LAS unsigned* st) {
    XcdBarrier b; b.bar = bar; b.x = xb_xcc_id(); b.st = st;
    if (threadIdx.x == 0) (void)xb_add(&bar[XB_XCNT(b.x)], 1u);
    return b;
}
__device__ __forceinline__ void xcd_barrier_complete(unsigned* bar, unsigned x, unsigned& nloc, unsigned& nx) {
    const unsigned G = gridDim.x * gridDim.y * gridDim.z;
    unsigned sum, cnt, mine, sp = 0u;
    for (;;) {
        sum = 0u; cnt = 0u; mine = 0u;
#pragma unroll
        for (unsigned j = 0; j < 16; ++j) { const unsigned c = xb_ld(&bar[XB_XCNT(j)]); sum += c; cnt += (c > 0u) ? 1u : 0u; mine = (j == x) ? c : mine; }
        if (sum == G) break;
        __builtin_amdgcn_s_sleep(1);
        if ((++sp & 255u) == 0u) { if (xb_ld(&bar[XB_TMO])) break; if (sp > XB_SPIN_CAP) { atomicAdd(&bar[XB_TMO], 1u); break; } }
    }
    nloc = mine > 0u ? mine : 1u; nx = cnt > 0u ? cnt : 1u;
}
__device__ __forceinline__ void xcd_barrier(const XcdBarrier& b) {
    asm volatile("s_waitcnt vmcnt(0)" ::: "memory");
    __syncthreads();
    if (threadIdx.x == 0) {
        unsigned* bar = b.bar;
        __builtin_amdgcn_s_waitcnt(0);
        unsigned nloc = b.st[0], nx = b.st[1];
        if (nloc == 0u) { xcd_barrier_complete(bar, b.x, nloc, nx); b.st[0] = nloc; b.st[1] = nx; }
        const unsigned old = xb_add(&bar[XB_XSUB(b.x)], 1u);
        const unsigned gen = old / nloc;
        if (old + 1u == (gen + 1u) * nloc) {
            __builtin_amdgcn_fence(__ATOMIC_RELEASE, "agent");
            asm volatile("s_waitcnt vmcnt(0)" ::: "memory");
            const unsigned og = xb_add(&bar[XB_TOP], 1u);
            const unsigned tg = og / nx;
            if (og + 1u == (tg + 1u) * nx) xb_add(&bar[XB_TOPGEN], 1u);
            else XB_SPIN(xb_ld(&bar[XB_TOPGEN]) == tg, bar);
            __builtin_amdgcn_fence(__ATOMIC_ACQUIRE, "agent");
            xb_add(&bar[XB_XGEN(b.x)], 1u);
            asm volatile("s_waitcnt vmcnt(0)" ::: "memory");
        } else {
            XB_SPIN(xb_ld(&bar[XB_XGEN(b.x)]) == gen, bar);
            __builtin_amdgcn_fence(__ATOMIC_ACQUIRE, "agent");
            asm volatile("s_waitcnt vmcnt(0)" ::: "memory");
        }
    }
    __syncthreads();
}

#define CGSYNC() do { asm volatile("s_waitcnt vmcnt(0) lgkmcnt(0)" ::: "memory"); grid.sync(); __builtin_amdgcn_fence(__ATOMIC_ACQUIRE, "agent"); asm volatile("s_waitcnt vmcnt(0)" ::: "memory"); } while (0)
#define GSYNC() xcd_barrier(xbar)

template <int CH>
__device__ __forceinline__ void mixer_chunk(const XcdBarrier& xbar, LAS unsigned char* lds, int G, int gw, int NGW, const bf16_t* H, const bf16_t* Win, const bf16_t* Wa, const bf16_t* Wb, const bf16_t* Wout,
        bf16_t* proj, bf16_t* og, float* lse, bf16_t* oa, bf16_t* ob, bf16_t* Z, bf16_t* Dbuf, const float* rope, const float* bgate, const float* rpb) {
    int tid_ = threadIdx.x; asm volatile("" : "+v"(tid_));
    const int tid = tid_, lane = tid & 63, wid = __builtin_amdgcn_readfirstlane(tid >> 6);
    pg8::StaticOrder SO;
    const int gwx = ((G % 8 == 0) ? ((int)(blockIdx.x % 8) * (G / 8) + (int)(blockIdx.x / 8)) : (int)blockIdx.x) * NWAVES + wid;

        constexpr int ch = CH; constexpr int S = (CH == 0) ? 8192 : 16384;
        const bf16_t* Hc = H + (size_t)ch * TC * DM;
        { pg8::Gemm g{Hc, Win, TC, INW, DM}; SO.init(TC, INW, G, blockIdx.x); EpiProj E{proj, rope, bgate, S - 1, (S == 8192) ? 13 : 14}; pg8::gemm_phase(lds, g, SO, E); }
        GSYNC();
        {
            LAS unsigned char* wl = lds + wid * WAVE_LDS;
            for (int u = gwx; u < 3 * 4 * (TC / 32); u += NGW) { if (!SKIP_A) attnA_unit(u, proj, og, lse, S, wl, lane); }
        }
        GSYNC();
        {
            LAS float* rpbL = (LAS float*)(lds + RPB_OFF);
            for (int i = tid; i < 8 * 465; i += NTHR) rpbL[i] = rpb[i] * LOG2E;
            __syncthreads();
            LAS unsigned char* wl = lds + wid * WAVE_LDS;
            for (int u = gwx; u < 8 * (TC / 32); u += NGW) { if (!SKIP_B) attnB_unit(u, proj, ob, S, wl, rpbL, lane); }
            for (int i = blockIdx.x * NTHR + tid; i < TC * 32; i += G * NTHR) {
                const int tl = i >> 5, h = (i >> 3) & 3, c8 = i & 7;
                const float l0 = lse[tl * 12 + h], l1 = lse[tl * 12 + 4 + h], l2 = lse[tl * 12 + 8 + h];
                const float mx = fmaxf(l0, fmaxf(l1, l2));
                float e0 = fexp2(l0 - mx), e1 = fexp2(l1 - mx), e2 = fexp2(l2 - mx);
                const float is = frcp(e0 + e1 + e2); e0 *= is; e1 *= is; e2 *= is;
                const bf16_t* p = og + (size_t)tl * 768 + h * 64 + c8 * 8;
                const u32x4 v0 = *(const u32x4*)p, v1 = *(const u32x4*)(p + 256), v2 = *(const u32x4*)(p + 512);
                u32x4 w;
                w.x = cvt_pk_bf16(e0 * bf_lo(v0.x) + e1 * bf_lo(v1.x) + e2 * bf_lo(v2.x), e0 * bf_hi(v0.x) + e1 * bf_hi(v1.x) + e2 * bf_hi(v2.x));
                w.y = cvt_pk_bf16(e0 * bf_lo(v0.y) + e1 * bf_lo(v1.y) + e2 * bf_lo(v2.y), e0 * bf_hi(v0.y) + e1 * bf_hi(v1.y) + e2 * bf_hi(v2.y));
                w.z = cvt_pk_bf16(e0 * bf_lo(v0.z) + e1 * bf_lo(v1.z) + e2 * bf_lo(v2.z), e0 * bf_hi(v0.z) + e1 * bf_hi(v1.z) + e2 * bf_hi(v2.z));
                w.w = cvt_pk_bf16(e0 * bf_lo(v0.w) + e1 * bf_lo(v1.w) + e2 * bf_lo(v2.w), e0 * bf_hi(v0.w) + e1 * bf_hi(v1.w) + e2 * bf_hi(v2.w));
                *(u32x4*)(oa + (size_t)tl * 256 + h * 64 + c8 * 8) = w;
            }
        }
        GSYNC();
        { pg8::Gemm g{oa, Wa, TC, DM, 256}; SO.init(TC, DM, G, blockIdx.x); EpiGate<false> E{Z, proj, 0}; pg8::gemm_phase(lds, g, SO, E); }
        { pg8::Gemm g{ob, Wb, TC, DM, 512}; SO.init(TC, DM, G, blockIdx.x); EpiGate<true> E{Z, proj, DM}; pg8::gemm_phase(lds, g, SO, E); }
        GSYNC();
        { pg8::Gemm g{Z, Wout, TC, DM, DM}; SO.init(TC, DM, G, blockIdx.x); EpiPlain E{Dbuf + (size_t)ch * TC * DM, DM}; pg8::gemm_phase(lds, g, SO, E); }

}

__global__ void __launch_bounds__(NTHR, 2) enc_fwd(Args a) {
    extern __shared__ __attribute__((aligned(16))) unsigned char lds_raw[];
    LAS unsigned char* lds = (LAS unsigned char*)lds_raw;
    cg::grid_group grid = cg::this_grid();
    const int tid = threadIdx.x, lane = tid & 63, wid = __builtin_amdgcn_readfirstlane(tid >> 6);
    const int G = gridDim.x, gw = blockIdx.x * NWAVES + wid, NGW = G * NWAVES;
    unsigned char* ws = a.ws;
    const float* x_p = a.in[0]; const float* x_s = a.in[1];
    bf16_t* Wgu1 = (bf16_t*)(ws + WS_WGU1); bf16_t* Wd1 = (bf16_t*)(ws + WS_WD1); bf16_t* Win = (bf16_t*)(ws + WS_WIN);
    bf16_t* Wa = (bf16_t*)(ws + WS_WA); bf16_t* Wb = (bf16_t*)(ws + WS_WB); bf16_t* Wout = (bf16_t*)(ws + WS_WOUT);
    bf16_t* Wgu2 = (bf16_t*)(ws + WS_WGU2); bf16_t* Wd2 = (bf16_t*)(ws + WS_WD2);
    float* rope = (float*)(ws + WS_ROPE); float* lse = (float*)(ws + WS_LSE);
    bf16_t* H = (bf16_t*)(ws + WS_H); bf16_t* A1 = (bf16_t*)(ws + WS_A1); bf16_t* Dbuf = (bf16_t*)(ws + WS_D); bf16_t* XB = (bf16_t*)(ws + WS_XB);
    bf16_t* proj = (bf16_t*)(ws + WS_PROJ); bf16_t* og = (bf16_t*)(ws + WS_OG); bf16_t* oa = (bf16_t*)(ws + WS_OA); bf16_t* ob = (bf16_t*)(ws + WS_OB); bf16_t* Z = (bf16_t*)(ws + WS_Z);
    float* out = a.out;
    volatile LAS unsigned* xst = (volatile LAS unsigned*)(lds + 131072 + 15360);
    if (tid < 2) xst[tid] = 0u;
    __syncthreads();
    const XcdBarrier xbar = xcd_barrier_post((unsigned*)(ws + WS_BAR), xst);
    grid.sync();

    {
        LAS float* scr = (LAS float*)(lds + wid * 16384);
        transpose_items<1>(a.in[4], a.in[5], FF, Wgu1, DM, 2 * FF, scr, lane, gw, NGW);
        transpose_items<0>(a.in[6], nullptr, DM, Wd1, FF, DM, scr, lane, gw, NGW);
        transpose_items<2>(a.in[9], nullptr, INW, Win, DM, INW, scr, lane, gw, NGW);
        transpose_items<0>(a.in[12], nullptr, DM, Wa, 256, DM, scr, lane, gw, NGW);
        transpose_items<0>(a.in[13], nullptr, DM, Wb, 512, DM, scr, lane, gw, NGW);
        transpose_items<0>(a.in[14], nullptr, DM, Wout, DM, DM, scr, lane, gw, NGW);
        transpose_items<1>(a.in[17], a.in[18], FF, Wgu2, DM, 2 * FF, scr, lane, gw, NGW);
        transpose_items<0>(a.in[19], nullptr, DM, Wd2, FF, DM, scr, lane, gw, NGW);
        for (int i = blockIdx.x * NTHR + tid; i < 16384 * 8; i += G * NTHR) {
            const int pos = i >> 3, f = i & 7;
            const double invf = (f == 0) ? 1.0 : (f == 1) ? 0.19392274474868576 : (f == 2) ? 0.03760603093086393 : (f == 3) ? 0.007292664737217109 : (f == 4) ? 0.001414213562373095
                              : (f == 5) ? 0.0002742481756762073 : (f == 6) ? 5.318295896944988e-05 : 1.031338537721246e-05;
            const float angf = (float)pos * (float)invf;
            double tt = (double)angf * 0.15915494309189535; tt -= floor(tt);
            const float fr = (float)tt;
            rope[pos * 16 + f] = __builtin_amdgcn_cosf(fr); rope[pos * 16 + 8 + f] = __builtin_amdgcn_sinf(fr);
        }
        row_pass<false, true, false, false>(x_p, x_s, nullptr, nullptr, nullptr, 0.f, nullptr, nullptr, a.in[2], H, lane, gw, NGW);
    }
    GSYNC();
    pg8::StaticOrder SO;
    { pg8::Gemm g{H, Wgu1, TALL, 2 * FF, DM}; SO.init(TALL, 2 * FF, G, blockIdx.x); EpiSwiglu E{A1}; pg8::gemm_phase(lds, g, SO, E); }
    GSYNC();
    { pg8::Gemm g{A1, Wd1, TALL, DM, FF}; SO.init(TALL, DM, G, blockIdx.x); EpiPlain E{Dbuf, DM}; pg8::gemm_phase(lds, g, SO, E); }
    GSYNC();
    row_pass<true, true, false, true>(x_p, x_s, nullptr, Dbuf, a.in[3], 0.5f, nullptr, XB, a.in[7], H, lane, gw, NGW);
    GSYNC();
    if (STOP_AFTER <= 1) return;
    if (STOP_AFTER <= 1) return;
    mixer_chunk<0>(xbar, lds, G, gw, NGW, H, Win, Wa, Wb, Wout, proj, og, lse, oa, ob, Z, Dbuf, rope, a.in[10], a.in[11]);
    mixer_chunk<1>(xbar, lds, G, gw, NGW, H, Win, Wa, Wb, Wout, proj, og, lse, oa, ob, Z, Dbuf, rope, a.in[10], a.in[11]);
    mixer_chunk<2>(xbar, lds, G, gw, NGW, H, Win, Wa, Wb, Wout, proj, og, lse, oa, ob, Z, Dbuf, rope, a.in[10], a.in[11]);
    GSYNC();
    row_pass<true, true, true, true>(nullptr, nullptr, XB, Dbuf, a.in[8], 1.0f, nullptr, XB, a.in[15], H, lane, gw, NGW);
    GSYNC();
    if (STOP_AFTER <= 2) return;
    if (STOP_AFTER <= 2) return;
    { pg8::Gemm g{H, Wgu2, TALL, 2 * FF, DM}; SO.init(TALL, 2 * FF, G, blockIdx.x); EpiSwiglu E{A1}; pg8::gemm_phase(lds, g, SO, E); }
    GSYNC();
    { pg8::Gemm g{A1, Wd2, TALL, DM, FF}; SO.init(TALL, DM, G, blockIdx.x); EpiPlain E{Dbuf, DM}; pg8::gemm_phase(lds, g, SO, E); }
    GSYNC();
    row_pass<true, false, true, false>(nullptr, nullptr, XB, Dbuf, a.in[16], 0.5f, out, nullptr, nullptr, nullptr, lane, gw, NGW);
}

extern "C" void kernel_launch(void* const* d_in, const int* in_sizes, int n_in, void* d_out, int out_size, void* d_ws, size_t ws_size, hipStream_t stream) {
    static int grid = 0;
    if (grid == 0) {
        if (n_in != 20 || out_size != TALL * DM || ws_size < WS_END) { fprintf(stderr, "kernel_launch: unexpected shapes (n_in %d out %d ws %zu)\n", n_in, out_size, ws_size); grid = -1; return; }
        int dev = 0, cus = 0, per_cu = 0;
        hipGetDevice(&dev);
        hipDeviceGetAttribute(&cus, hipDeviceAttributeMultiprocessorCount, dev);
        hipFuncSetAttribute((const void*)enc_fwd, hipFuncAttributeMaxDynamicSharedMemorySize, LDS_BYTES);
        hipOccupancyMaxActiveBlocksPerMultiprocessor(&per_cu, (const void*)enc_fwd, NTHR, LDS_BYTES);
        if (per_cu < 1) per_cu = 1;
        grid = cus * per_cu;
        (void)hipGetLastError();
    }
    if (grid < 0) return;
    if (hipMemsetAsync((char*)d_ws + WS_BAR, 0, 16384, stream) != hipSuccess) { fprintf(stderr, "memset of barrier words failed\n"); return; }
    Args a{};
    for (int i = 0; i < 20; ++i) a.in[i] = (const float*)d_in[i];
    a.out = (float*)d_out; a.ws = (unsigned char*)d_ws;
    void* args[] = {&a};
    hipError_t e = hipLaunchCooperativeKernel((const void*)enc_fwd, dim3(grid), dim3(NTHR), args, LDS_BYTES, stream);
    if (e != hipSuccess) fprintf(stderr, "cooperative launch failed: %s (grid %d)\n", hipGetErrorString(e), grid);
}
```

```cpp
#include <hip/hip_runtime.h>
#include <hip/hip_cooperative_groups.h>
#include <cstdio>
#include <cstdint>
namespace cg = cooperative_groups;

#define LAS __attribute__((address_space(3)))
typedef unsigned short bf16_t;
typedef short bf16x8 __attribute__((ext_vector_type(8)));
typedef short s16x4 __attribute__((ext_vector_type(4)));
typedef float f32x4 __attribute__((ext_vector_type(4)));
typedef float f32x16 __attribute__((ext_vector_type(16)));
typedef unsigned u32x4 __attribute__((ext_vector_type(4)));
typedef unsigned u32x2 __attribute__((ext_vector_type(2)));

constexpr int DM = 1024, FF = 2816, TALL = 49152, TP = 16384, TC = 16384, NCH = 3;
constexpr int INW = 5888, GOFF = 3840;
constexpr int HSL = TC * 64;
constexpr int GPITCH = 2048;
constexpr int NWAVES = 8, NTHR = 512;
constexpr float RMS_EPS = 1e-6f;
constexpr float LOG2E = 1.4426950408889634f;
constexpr float QSCALE = 0.125f * LOG2E;
constexpr float NEGBIG = -1e30f;

constexpr size_t MiB = 1u << 20;
constexpr size_t WS_WGU1 = 0, WS_WD1 = 11 * MiB, WS_WIN = 16 * MiB + MiB / 2, WS_WA = 28 * MiB, WS_WB = 28 * MiB + MiB / 2, WS_WOUT = 29 * MiB + MiB / 2,
                 WS_WGU2 = 31 * MiB + MiB / 2, WS_WD2 = 42 * MiB + MiB / 2, WS_ROPE = 48 * MiB, WS_LSE = 49 * MiB;
constexpr size_t WS_H = 50 * MiB;
constexpr size_t WS_A1 = 146 * MiB;
constexpr size_t WS_D = WS_H;
constexpr size_t WS_XB = 410 * MiB;
constexpr size_t WS_BAR = 506 * MiB;
constexpr size_t WS_END = 507 * MiB;
constexpr size_t WS_PROJ = 146 * MiB;
constexpr size_t WS_OG = 330 * MiB;
constexpr size_t WS_OA = 354 * MiB;
constexpr size_t WS_OB = 362 * MiB;
constexpr size_t WS_Z = 378 * MiB;

#ifndef STOP_AFTER
#define STOP_AFTER 99
#endif
#ifndef SKIP_A
#define SKIP_A 0
#endif
#ifndef SKIP_B
#define SKIP_B 0
#endif
constexpr int LDS_BYTES = 131072 + 16384;

typedef float f32x2_t __attribute__((ext_vector_type(2))); typedef __bf16 bf16x2_t __attribute__((ext_vector_type(2)));
__device__ __forceinline__ unsigned cvt_pk_bf16(float lo, float hi) { f32x2_t v = {lo, hi}; bf16x2_t b = __builtin_convertvector(v, bf16x2_t); return __builtin_bit_cast(unsigned, b); }
__device__ __forceinline__ float bf_lo(unsigned u) { return __uint_as_float(u << 16); }
__device__ __forceinline__ float bf_hi(unsigned u) { return __uint_as_float(u & 0xffff0000u); }
__device__ __forceinline__ float fexp2(float x) { return __builtin_amdgcn_exp2f(x); }
__device__ __forceinline__ float frcp(float x) { return __builtin_amdgcn_rcpf(x); }
__device__ __forceinline__ float sigmoidf_(float x) { return frcp(1.0f + fexp2(-x * LOG2E)); }
__device__ __forceinline__ float wave_sum(float v) {
#pragma unroll
    for (int o = 1; o < 64; o <<= 1) v += __shfl_xor(v, o);
    return v;
}

namespace pg8 {
constexpr int BM = 256, BK = 64, HALF = 128, HTB = HALF * BK * 2, STAGE_BYTES = 8 * HTB, NXCD = 8, WGM = 4;
__host__ __device__ __forceinline__ int lds_byte(int r, int c) { const int st = (r >> 4) * 2 + (c >> 5), rr = r & 15, cc = c & 31, ob = rr * 64 + cc * 2; return st * 1024 + (ob ^ (((ob >> 9) & 1) << 5)); }
__host__ __device__ __forceinline__ void stage_rc(int b, int& R, int& C) { const int st = b / 1024, sb = b % 1024, swz = sb ^ (((sb >> 9) & 1) << 5); R = (st >> 1) * 16 + swz / 64; C = (st & 1) * 32 + (swz % 64) / 2; }
__host__ __device__ __forceinline__ int perm32(int rho) { const int n = rho >> 4, i = rho & 15; return 8 * (i >> 2) + 4 * n + (i & 3); }

struct Unit { int pm, pn; };
struct Gemm { const bf16_t* A; const bf16_t* Bt; int M, N, K; };

struct StaticOrder {
    int nM, nN, nwg, G, c;
    __device__ void init(int M, int N, int G_, int c_) { nM = M / BM; nN = N / BM; nwg = nM * nN; G = G_; c = c_; }
    __device__ bool next(int i, Unit& u) const {
        const long L = (long)i * G + c; if (L >= nwg) return false;
        int wgid = (int)L; { const int q = nwg / NXCD, r = nwg % NXCD, xcd = wgid % NXCD, off = wgid / NXCD; wgid = (xcd < r ? xcd * (q + 1) : r * (q + 1) + (xcd - r) * q) + off; }
        const int wgm = (nN <= 4) ? 8 : 4;
        const int nig = wgm * nN, gid = wgid / nig, fm = gid * wgm, gsz = (nM - fm) < wgm ? (nM - fm) : wgm;
        u.pm = fm + ((wgid % nig) % gsz); u.pn = (wgid % nig) / gsz; return true;
    }
};

template <class Epi>
__device__ __forceinline__ void gemm_phase(LAS unsigned char* lds, const Gemm g, const StaticOrder& S, const Epi& E) {
    int tid_ = threadIdx.x; asm volatile("" : "+v"(tid_));
    const int tid = tid_, wid = __builtin_amdgcn_readfirstlane(tid >> 6), lane = tid & 63, wr = wid >> 2, wc = wid & 3, fr = lane & 15, fq = lane >> 4;
    const int K = g.K, nt = K / BK;
    unsigned voffA[2], voffB[2];
#pragma unroll
    for (int i = 0; i < 2; ++i) { int R, C; stage_rc(tid * 16 + i * 8192, R, C); const int Rb = (R & ~31) + perm32(R & 31);
        voffA[i] = (unsigned)(R * K + C) * 2u; voffB[i] = (unsigned)(Rb * K + C) * 2u; }
    const size_t kstep = (size_t)(BK * 2);
    const size_t hstep = (size_t)HALF * K * 2;
    const size_t tstep = 2 * hstep;
    const unsigned ldsw = (unsigned)wid * 1024u;
    const int aoff = lds_byte(wr * 64 + fr, fq * 8), boff = lds_byte(wc * 32 + fr, fq * 8);
#define PG8_SA(b, h) (((b) * 2 + (h)) * HTB)
#define PG8_SB(b, h) ((4 + (b) * 2 + (h)) * HTB)
#define PG8_STAGE(bufoff, gbase, voff) do { _Pragma("unroll") for (int _i = 0; _i < 2; ++_i) \
        __builtin_amdgcn_global_load_lds((const __attribute__((address_space(1))) unsigned*)((const char*)(gbase) + (voff)[_i]), (LAS unsigned*)(lds + (bufoff) + ldsw + _i * 8192), 16, 0, 0); } while (0)
#define PG8_LDA(dst, b, h) do { _Pragma("unroll") for (int m = 0; m < 4; ++m) _Pragma("unroll") for (int k = 0; k < 2; ++k) dst[m][k] = *(const LAS bf16x8*)(lds + PG8_SA(b, h) + aoff + m * 2048 + k * 1024); } while (0)
#define PG8_LDB(dst, b, h) do { _Pragma("unroll") for (int n = 0; n < 2; ++n) _Pragma("unroll") for (int k = 0; k < 2; ++k) dst[n][k] = *(const LAS bf16x8*)(lds + PG8_SB(b, h) + boff + n * 2048 + k * 1024); } while (0)
#define PG8_MMA(ai, bj, At, Bt) do { __builtin_amdgcn_s_setprio(1); _Pragma("unroll") for (int m = 0; m < 4; ++m) _Pragma("unroll") for (int n = 0; n < 2; ++n) _Pragma("unroll") for (int k = 0; k < 2; ++k) \
        acc[ai][bj][m][n] = __builtin_amdgcn_mfma_f32_16x16x32_bf16(Bt[n][k], At[m][k], acc[ai][bj][m][n], 0, 0, 0); __builtin_amdgcn_s_setprio(0); } while (0)
#define PG8_WAIT_V(n) asm volatile("s_waitcnt vmcnt(" #n ")" ::: "memory")
#define PG8_WAIT_L(n) asm volatile("s_waitcnt lgkmcnt(" #n ")" ::: "memory")
#define PG8_BAR __builtin_amdgcn_s_barrier()
#define PG8_SCHED __builtin_amdgcn_sched_barrier(0)
    Unit cur, nxt; int ui = 0;
    if (!S.next(0, cur)) return;
    f32x4 acc[2][2][4][2];
#pragma unroll
    for (int a = 0; a < 2; ++a)
#pragma unroll
        for (int b = 0; b < 2; ++b)
#pragma unroll
            for (int m = 0; m < 4; ++m)
#pragma unroll
                for (int n = 0; n < 2; ++n) acc[a][b][m][n] = (f32x4){0.f, 0.f, 0.f, 0.f};
    bf16x8 At[4][2], B0[2][2], B1[2][2];
    const char* cA = (const char*)g.A + (size_t)cur.pm * tstep; const char* cB = (const char*)g.Bt + (size_t)cur.pn * tstep;
    PG8_STAGE(PG8_SB(0, 0), cB, voffB); PG8_STAGE(PG8_SB(0, 1), cB + hstep, voffB); PG8_STAGE(PG8_SA(0, 0), cA, voffA); PG8_STAGE(PG8_SA(0, 1), cA + hstep, voffA);
    if (wr == 1) PG8_BAR;
    PG8_WAIT_V(2); PG8_BAR;
    PG8_STAGE(PG8_SB(1, 0), cB + kstep, voffB); PG8_STAGE(PG8_SA(1, 0), cA + kstep, voffA); PG8_STAGE(PG8_SB(1, 1), cB + hstep + kstep, voffB);
    PG8_WAIT_V(6); PG8_BAR;
    for (;;) {
        const bool has_next = S.next(ui + 1, nxt);
        const char* nA = has_next ? (const char*)g.A + (size_t)nxt.pm * tstep : cA; const char* nB = has_next ? (const char*)g.Bt + (size_t)nxt.pn * tstep : cB;
#pragma nounroll
        for (int t = 0; t < nt; t += 2) {
            const bool last = (t == nt - 2);
            const char* a1 = cA + (size_t)(t + 1) * kstep;
            const char* a2 = last ? nA : cA + (size_t)(t + 2) * kstep; const char* b2 = last ? nB : cB + (size_t)(t + 2) * kstep;
            const char* a3 = a2 + kstep; const char* b3 = b2 + kstep;
            PG8_LDB(B0, 0, 0); PG8_LDB(B1, 0, 1); PG8_SCHED; PG8_LDA(At, 0, 0); PG8_STAGE(PG8_SA(1, 1), a1 + hstep, voffA);
            PG8_WAIT_V(8); PG8_WAIT_L(0); PG8_BAR; PG8_MMA(0, 0, At, B0); PG8_MMA(0, 1, At, B1); PG8_BAR; PG8_SCHED;
            PG8_LDA(At, 0, 1); PG8_STAGE(PG8_SB(0, 0), b2, voffB); PG8_STAGE(PG8_SB(0, 1), b2 + hstep, voffB); PG8_STAGE(PG8_SA(0, 0), a2, voffA);
            PG8_WAIT_V(8); PG8_WAIT_L(0); PG8_BAR; PG8_MMA(1, 0, At, B0); PG8_MMA(1, 1, At, B1); PG8_BAR; PG8_SCHED;
            PG8_LDB(B0, 1, 0); PG8_LDB(B1, 1, 1); PG8_SCHED; PG8_LDA(At, 1, 0); PG8_STAGE(PG8_SA(0, 1), a2 + hstep, voffA);
            PG8_WAIT_V(8); PG8_WAIT_L(0); PG8_BAR; PG8_MMA(0, 0, At, B0); PG8_MMA(0, 1, At, B1); PG8_BAR; PG8_SCHED;
            PG8_LDA(At, 1, 1); PG8_STAGE(PG8_SB(1, 0), b3, voffB); PG8_STAGE(PG8_SB(1, 1), b3 + hstep, voffB); PG8_STAGE(PG8_SA(1, 0), a3, voffA);
            PG8_WAIT_V(8); PG8_WAIT_L(0); PG8_BAR; PG8_MMA(1, 0, At, B0); PG8_MMA(1, 1, At, B1); PG8_BAR; PG8_SCHED;
        }
        if (wr == 0) PG8_BAR;
        E(acc, cur, wr, wc, fr, fq);
        if (!has_next) break;
#pragma unroll
        for (int a = 0; a < 2; ++a)
#pragma unroll
            for (int b = 0; b < 2; ++b)
#pragma unroll
                for (int m = 0; m < 4; ++m)
#pragma unroll
                    for (int n = 0; n < 2; ++n) acc[a][b][m][n] = (f32x4){0.f, 0.f, 0.f, 0.f};
        cur = nxt; cA = nA; cB = nB; ++ui;
        if (wr == 1) PG8_BAR;
    }
    PG8_WAIT_V(0);
    PG8_BAR;
#undef PG8_SA
#undef PG8_SB
#undef PG8_STAGE
#undef PG8_LDA
#undef PG8_LDB
#undef PG8_MMA
#undef PG8_WAIT_V
#undef PG8_WAIT_L
#undef PG8_BAR
#undef PG8_SCHED
}
}
using pg8::Unit;

typedef f32x4 AccT[2][2][4][2];

#define OPAQUE(o) asm volatile("" : "+v"(o))
struct EpiPlain {
    bf16_t* O; int ldc;
    __device__ __forceinline__ void operator()(const AccT& acc, const Unit& u, int wr, int wc, int fr, int fq) const {
        const unsigned lo = (unsigned)((u.pm * 256 + wr * 64 + fr) * ldc + u.pn * 256 + wc * 32 + 8 * fq) * 2u;
#pragma unroll
        for (int ai = 0; ai < 2; ++ai)
#pragma unroll
            for (int m = 0; m < 4; ++m) { unsigned o = lo + (unsigned)((ai * 128 + m * 16) * ldc) * 2u; OPAQUE(o); char* rowp = (char*)O + o;
#pragma unroll
                for (int bj = 0; bj < 2; ++bj) { const f32x4 v0 = acc[ai][bj][m][0], v1 = acc[ai][bj][m][1];
                    u32x4 w; w.x = cvt_pk_bf16(v0[0], v0[1]); w.y = cvt_pk_bf16(v0[2], v0[3]); w.z = cvt_pk_bf16(v1[0], v1[1]); w.w = cvt_pk_bf16(v1[2], v1[3]);
                    *(u32x4*)(rowp + bj * 256) = w; } }
    }
};
struct EpiSwiglu {
    bf16_t* O;
    __device__ __forceinline__ void operator()(const AccT& acc, const Unit& u, int wr, int wc, int fr, int fq) const {
        const unsigned lo = (unsigned)((u.pm * 256 + wr * 64 + fr) * FF + u.pn * 128 + wc * 32 + 8 * fq) * 2u;
#pragma unroll
        for (int ai = 0; ai < 2; ++ai)
#pragma unroll
            for (int m = 0; m < 4; ++m) { unsigned o = lo + (unsigned)((ai * 128 + m * 16) * FF) * 2u; OPAQUE(o); char* rowp = (char*)O + o;
                float r[8];
#pragma unroll
                for (int n = 0; n < 2; ++n)
#pragma unroll
                    for (int j = 0; j < 4; ++j) { const float gt = acc[ai][0][m][n][j], up = acc[ai][1][m][n][j]; r[n * 4 + j] = gt * sigmoidf_(gt) * up; }
                u32x4 w; w.x = cvt_pk_bf16(r[0], r[1]); w.y = cvt_pk_bf16(r[2], r[3]); w.z = cvt_pk_bf16(r[4], r[5]); w.w = cvt_pk_bf16(r[6], r[7]);
                *(u32x4*)rowp = w; }
    }
};
struct EpiProj {
    bf16_t* O; const float* rope; const float* bgate; int posmask; int lgS;
    __device__ __forceinline__ void operator()(const AccT& acc, const Unit& u, int wr, int wc, int fr, int fq) const {
        const int pn = u.pn;
        const int row0 = u.pm * 256 + wr * 64 + fr, col0 = pn * 256 + wc * 32 + 8 * fq;
        const bool ropeTile = pn < 6, gateTile = pn >= 15;
        const float sc = (pn < 3 || pn == 9 || pn == 10) ? QSCALE : 1.0f;
        const bool rot = ropeTile && ((wc & 1) == 0) && (fq < 2);
        if (gateTile) {
            const unsigned lo = (unsigned)(3840 * TC + row0 * GPITCH + (col0 - GOFF)) * 2u;
#pragma unroll
            for (int bj = 0; bj < 2; ++bj) { const f32x4 b0 = *(const f32x4*)(bgate + col0 - GOFF + bj * 128), b1 = *(const f32x4*)(bgate + col0 - GOFF + bj * 128 + 4);
#pragma unroll
                for (int ai = 0; ai < 2; ++ai)
#pragma unroll
                    for (int m = 0; m < 4; ++m) { unsigned o = lo + (unsigned)((ai * 128 + m * 16) * GPITCH) * 2u + bj * 256; OPAQUE(o);
                        f32x4 v0 = acc[ai][bj][m][0] + b0, v1 = acc[ai][bj][m][1] + b1;
#pragma unroll
                        for (int j = 0; j < 4; ++j) { v0[j] = sigmoidf_(v0[j]); v1[j] = sigmoidf_(v1[j]); }
                        u32x4 w; w.x = cvt_pk_bf16(v0[0], v0[1]); w.y = cvt_pk_bf16(v0[2], v0[3]); w.z = cvt_pk_bf16(v1[0], v1[1]); w.w = cvt_pk_bf16(v1[2], v1[3]);
                        *(u32x4*)((char*)O + o) = w; } }
        } else {
            const int dsh = (pn < 9) ? 2 * (pn % 3) : 0;
            const int hs0 = pn * 4 + (wc >> 1);
            const unsigned hoff = (unsigned)(hs0 * HSL + 32 * (wc & 1) + 8 * fq) * 2u;
#pragma unroll
            for (int ai = 0; ai < 2; ++ai) {
                f32x4 csv[4], snv[4];
#pragma unroll
                for (int m = 0; m < 4; ++m) { csv[m] = (f32x4){1.f, 1.f, 1.f, 1.f}; snv[m] = (f32x4){0.f, 0.f, 0.f, 0.f}; }
                if (ropeTile) {
#pragma unroll
                    for (int m = 0; m < 4; ++m) { unsigned ro = (unsigned)(((row0 + ai * 128 + m * 16) & posmask) * 16 + 4 * (fq & 1)) * 4u; OPAQUE(ro);
                        const f32x4 c = *(const f32x4*)((const char*)rope + ro), s = *(const f32x4*)((const char*)rope + ro + 32);
                        csv[m] = rot ? c : csv[m]; snv[m] = rot ? s : snv[m]; }
                }
#pragma unroll
                for (int m = 0; m < 4; ++m) { const int row = row0 + ai * 128 + m * 16, t = row & posmask;
                    const int pos = (row - t) + ((t & ((1 << dsh) - 1)) << (lgS - dsh)) + (t >> dsh);
                    unsigned o = hoff + (unsigned)pos * 128u; OPAQUE(o);
                    const f32x4 cs = csv[m], sn = snv[m];
#pragma unroll
                    for (int bj = 0; bj < 2; ++bj) { f32x4 v0 = acc[ai][bj][m][0], v1 = acc[ai][bj][m][1];
                        if (ropeTile) { const f32x4 x1 = v0, x2 = v1; v0 = x1 * cs - x2 * sn; v1 = x2 * cs + x1 * sn; }
                        v0 = v0 * sc; v1 = v1 * sc;
                        u32x4 w; w.x = cvt_pk_bf16(v0[0], v0[1]); w.y = cvt_pk_bf16(v0[2], v0[3]); w.z = cvt_pk_bf16(v1[0], v1[1]); w.w = cvt_pk_bf16(v1[2], v1[3]);
                        *(u32x4*)((char*)O + o + (unsigned)(bj * 2 * HSL) * 2u) = w; }
                    asm volatile("" ::: "memory"); }
            }
        }
    }
};
template <bool ADD> struct EpiGate {
    bf16_t* Z; const bf16_t* P; int goff;
    __device__ __forceinline__ void operator()(const AccT& acc, const Unit& u, int wr, int wc, int fr, int fq) const {
        constexpr int RB = ADD ? 2 : 4;
        const int row0 = u.pm * 256 + wr * 64 + fr, col0 = u.pn * 256 + wc * 32 + 8 * fq;
        const unsigned zl = (unsigned)(row0 * DM + col0) * 2u, gl = (unsigned)(3840 * TC + row0 * GPITCH + goff + col0) * 2u;
#pragma unroll
        for (int ai = 0; ai < 2; ++ai)
#pragma unroll
            for (int mb = 0; mb < 4; mb += RB) {
                u32x4 gw[RB][2], zo[RB][2]; unsigned zoff[RB];
#pragma unroll
                for (int k = 0; k < RB; ++k) { const int m = mb + k;
                    unsigned zo_ = zl + (unsigned)((ai * 128 + m * 16) * DM) * 2u, go_ = gl + (unsigned)((ai * 128 + m * 16) * GPITCH) * 2u; OPAQUE(zo_); OPAQUE(go_);
                    zoff[k] = zo_;
#pragma unroll
                    for (int bj = 0; bj < 2; ++bj) { gw[k][bj] = *(const u32x4*)((const char*)P + go_ + bj * 256); if (ADD) zo[k][bj] = *(const u32x4*)((const char*)Z + zo_ + bj * 256); } }
#pragma unroll
                for (int k = 0; k < RB; ++k) { const int m = mb + k;
#pragma unroll
                    for (int bj = 0; bj < 2; ++bj) { const f32x4 v0 = acc[ai][bj][m][0], v1 = acc[ai][bj][m][1]; const u32x4 g = gw[k][bj];
                        float r[8];
                        r[0] = bf_lo(g.x) * v0[0]; r[1] = bf_hi(g.x) * v0[1]; r[2] = bf_lo(g.y) * v0[2]; r[3] = bf_hi(g.y) * v0[3];
                        r[4] = bf_lo(g.z) * v1[0]; r[5] = bf_hi(g.z) * v1[1]; r[6] = bf_lo(g.w) * v1[2]; r[7] = bf_hi(g.w) * v1[3];
                        if (ADD) { const u32x4 z = zo[k][bj];
                            r[0] += bf_lo(z.x); r[1] += bf_hi(z.x); r[2] += bf_lo(z.y); r[3] += bf_hi(z.y); r[4] += bf_lo(z.z); r[5] += bf_hi(z.z); r[6] += bf_lo(z.w); r[7] += bf_hi(z.w); }
                        u32x4 w; w.x = cvt_pk_bf16(r[0], r[1]); w.y = cvt_pk_bf16(r[2], r[3]); w.z = cvt_pk_bf16(r[4], r[5]); w.w = cvt_pk_bf16(r[6], r[7]);
                        *(u32x4*)((char*)Z + zoff[k] + bj * 256) = w; } }
                asm volatile("" ::: "memory"); }
    }
};

struct Args {
    const float* in[20];
    float* out;
    unsigned char* ws;
};

__device__ __forceinline__ void transpose_item(const float* W, int ldw, int sc, bf16_t* WT, int K, int n0, int k0, LAS float* scr, int lane) {
    float tv[32];
#pragma unroll
    for (int i = 0; i < 32; ++i) tv[i] = W[(size_t)(k0 + 2 * i + (lane >> 5)) * ldw + sc];
#pragma unroll
    for (int i = 0; i < 32; ++i) scr[(2 * i + (lane >> 5)) * 33 + (lane & 31)] = tv[i];
    asm volatile("s_waitcnt lgkmcnt(0)" ::: "memory");
    const int c = lane & 7;
#pragma unroll
    for (int j = 0; j < 4; ++j) { const int n = (lane >> 3) + 8 * j; const LAS float* s = scr + (8 * c) * 33 + n;
        u32x4 o; o.x = cvt_pk_bf16(s[0 * 33], s[1 * 33]); o.y = cvt_pk_bf16(s[2 * 33], s[3 * 33]); o.z = cvt_pk_bf16(s[4 * 33], s[5 * 33]); o.w = cvt_pk_bf16(s[6 * 33], s[7 * 33]);
        *(u32x4*)(WT + (size_t)(n0 + n) * K + k0 + 8 * c) = o; }
    asm volatile("s_waitcnt lgkmcnt(0)" ::: "memory");
}
template <int KIND>
__device__ __forceinline__ void transpose_items(const float* W0, const float* W1, int ldw, bf16_t* WT, int K, int N, LAS float* scr, int lane, int gw, int NGW) {
    const int nblk = N / 32, nitems = (K / 64) * nblk;
    for (int it = gw; it < nitems; it += NGW) {
        const int kb = it / nblk, nb = it % nblk, n0 = nb * 32, n = n0 + (lane & 31);
        const float* W = W0; int sc = n;
        if (KIND == 1) { const int tile = n >> 8, bj = (n >> 7) & 1, j = n & 127; W = bj ? W1 : W0; sc = tile * 128 + j; }
        if (KIND == 2) { if (n < 1536 && (n & 63) < 16) { const int p = n & 15; const int d = (p < 8) ? ((p & 3) + ((p >> 2) << 3)) : (4 + (p & 3) + (((p - 8) >> 2) << 3)); sc = (n & ~15) + d; } }
        transpose_item(W, ldw, sc, WT, K, n0, kb * 64, scr, lane);
    }
}

template <int KIND>
__device__ __forceinline__ void transpose_block(const float* W0, const float* W1, int ldw, bf16_t* WT, int K, int N, LAS float* scr, int tid, int bid, int G) {
    const int lane = tid & 63, wv = tid >> 6;
    const int nblk = N / 256, nitems = (K / 64) * nblk;
    for (int it = bid; it < nitems; it += G) {
        const int kb = it / nblk, nb = it % nblk, n0 = nb * 256, k0 = kb * 64;
        const float* src = W0 + n0 + 4 * lane;
        if (KIND == 1) src = (lane < 32) ? W0 + nb * 128 + 4 * lane : W1 + nb * 128 + 4 * (lane - 32);
        f32x4 tv[8];
#pragma unroll
        for (int i = 0; i < 8; ++i) tv[i] = *(const f32x4*)(src + (size_t)(k0 + wv * 8 + i) * ldw);
        int dpos[4];
#pragma unroll
        for (int j = 0; j < 4; ++j) { int s = 4 * lane + j;
            if (KIND == 2) { if (n0 + s < 1536 && (s & 63) < 16) { const int p = s & 15; const int d = (p < 8) ? ((p & 3) + ((p >> 2) << 3)) : (4 + (p & 3) + (((p - 8) >> 2) << 3)); s = (s & ~15) + d; } }
            dpos[j] = s; }
#pragma unroll
        for (int i = 0; i < 8; ++i)
#pragma unroll
            for (int j = 0; j < 4; ++j) scr[(wv * 8 + i) * 257 + dpos[j]] = tv[i][j];
        __syncthreads();
        const int c = tid & 7;
#pragma unroll
        for (int j = 0; j < 4; ++j) { const int n = (tid >> 3) + 64 * j; const LAS float* s = scr + (8 * c) * 257 + n;
            u32x4 o; o.x = cvt_pk_bf16(s[0 * 257], s[1 * 257]); o.y = cvt_pk_bf16(s[2 * 257], s[3 * 257]); o.z = cvt_pk_bf16(s[4 * 257], s[5 * 257]); o.w = cvt_pk_bf16(s[6 * 257], s[7 * 257]);
            *(u32x4*)(WT + (size_t)(n0 + n) * K + k0 + 8 * c) = o; }
        __syncthreads();
    }
}

template <bool HAS_D, bool HAS_H, bool XIN16, bool XOUT16>
__device__ __forceinline__ void row_pass(const float* xa, const float* xb, const bf16_t* x16in, const bf16_t* D, const float* gpost, float dscale, float* xout, bf16_t* x16out, const float* gpre, bf16_t* hout, int lane, int gw, int NGW) {
    f32x4 gp[4], gq[4];
#pragma unroll
    for (int j = 0; j < 4; ++j) { if (HAS_D) gp[j] = *(const f32x4*)(gpost + 4 * lane + 256 * j); if (HAS_H) gq[j] = *(const f32x4*)(gpre + 4 * lane + 256 * j); }
    for (int row = gw; row < TALL; row += NGW) {
        f32x4 v[4];
        if (XIN16) {
#pragma unroll
            for (int j = 0; j < 4; ++j) { const u32x2 w = *(const u32x2*)(x16in + (size_t)row * DM + 4 * lane + 256 * j); v[j] = (f32x4){bf_lo(w.x), bf_hi(w.x), bf_lo(w.y), bf_hi(w.y)}; }
        } else {
            const float* xr = (row < TP) ? xa + (size_t)row * DM : xb + (size_t)(row - TP) * DM;
#pragma unroll
            for (int j = 0; j < 4; ++j) v[j] = *(const f32x4*)(xr + 4 * lane + 256 * j);
        }
        if (HAS_D) {
            f32x4 d[4]; float ss = 0.f;
#pragma unroll
            for (int j = 0; j < 4; ++j) { const u32x2 w = *(const u32x2*)(D + (size_t)row * DM + 4 * lane + 256 * j);
                d[j] = (f32x4){bf_lo(w.x), bf_hi(w.x), bf_lo(w.y), bf_hi(w.y)}; ss += (d[j][0] * d[j][0] + d[j][1] * d[j][1]) + (d[j][2] * d[j][2] + d[j][3] * d[j][3]); }
            const float r = dscale * __builtin_amdgcn_rsqf(wave_sum(ss) * (1.0f / DM) + RMS_EPS);
#pragma unroll
            for (int j = 0; j < 4; ++j) { v[j] = v[j] + d[j] * gp[j] * r;
                if (XOUT16) { u32x2 w; w.x = cvt_pk_bf16(v[j][0], v[j][1]); w.y = cvt_pk_bf16(v[j][2], v[j][3]); *(u32x2*)(x16out + (size_t)row * DM + 4 * lane + 256 * j) = w; }
                else *(f32x4*)(xout + (size_t)row * DM + 4 * lane + 256 * j) = v[j]; }
        }
        if (HAS_H) {
            float ss = 0.f;
#pragma unroll
            for (int j = 0; j < 4; ++j) ss += (v[j][0] * v[j][0] + v[j][1] * v[j][1]) + (v[j][2] * v[j][2] + v[j][3] * v[j][3]);
            const float r = __builtin_amdgcn_rsqf(wave_sum(ss) * (1.0f / DM) + RMS_EPS);
#pragma unroll
            for (int j = 0; j < 4; ++j) { const f32x4 o = v[j] * gq[j] * r; u32x2 w; w.x = cvt_pk_bf16(o[0], o[1]); w.y = cvt_pk_bf16(o[2], o[3]);
                *(u32x2*)(hout + (size_t)row * DM + 4 * lane + 256 * j) = w; }
        }
    }
}

constexpr int WAVE_LDS = 16384;
constexpr int RPB_OFF = 131072;
__device__ __forceinline__ int crow(int r, int hi) { return (r & 3) + 8 * (r >> 2) + 4 * hi; }
__device__ __forceinline__ s16x4 vtr(LAS const unsigned char* p) { return __builtin_bit_cast(s16x4, __builtin_amdgcn_ds_read_tr16_b64_v4i16((LAS s16x4*)p)); }

struct KVRegs { u32x4 k[4], v[4]; };
#define F16Z (f32x16){0.f,0.f,0.f,0.f,0.f,0.f,0.f,0.f,0.f,0.f,0.f,0.f,0.f,0.f,0.f,0.f}

#define ATT_LOAD(R, posexpr) do { _Pragma("unroll") for (int _i = 0; _i < 4; ++_i) { const int _rowi = (lane >> 3) + 8 * _i; const size_t _off = (size_t)(posexpr) * 64 + 8 * (lane & 7); \
        R.k[_i] = *(const u32x4*)(kbase + _off); R.v[_i] = *(const u32x4*)(vbase + _off); } } while (0)
#define ATT_STORE(R, slot) do { _Pragma("unroll") for (int _i = 0; _i < 4; ++_i) { \
        *(LAS u32x4*)(wl + (slot) * 8192 + wst + _i * 1024) = R.k[_i]; *(LAS u32x4*)(wl + (slot) * 8192 + 4096 + wst + _i * 1024) = R.v[_i]; } } while (0)
#define ATT_QK(s, slot) do { s = F16Z; _Pragma("unroll") for (int _d = 0; _d < 4; ++_d) { \
        const bf16x8 _kf = *(const LAS bf16x8*)(wl + (slot) * 8192 + q32 * 128 + ((kx ^ (2 * _d)) << 4)); s = __builtin_amdgcn_mfma_f32_32x32x16_bf16(_kf, qr[_d], s, 0, 0, 0); } } while (0)
#define ATT_PACK(p0, p1, s) do { u32x4 _a, _b; _a.x = cvt_pk_bf16(s[0], s[1]); _a.y = cvt_pk_bf16(s[2], s[3]); _a.z = cvt_pk_bf16(s[4], s[5]); _a.w = cvt_pk_bf16(s[6], s[7]); \
        _b.x = cvt_pk_bf16(s[8], s[9]); _b.y = cvt_pk_bf16(s[10], s[11]); _b.z = cvt_pk_bf16(s[12], s[13]); _b.w = cvt_pk_bf16(s[14], s[15]); \
        p0 = __builtin_bit_cast(bf16x8, _a); p1 = __builtin_bit_cast(bf16x8, _b); } while (0)
#define ATT_PV(slot, p0, p1) do { LAS const unsigned char* _v0 = wl + (slot) * 8192 + 4096 + vb0; LAS const unsigned char* _v1 = wl + (slot) * 8192 + 4096 + (vb0 ^ 64); \
        { const s16x4 a = vtr(_v0), b = vtr(_v0 + 1024); const bf16x8 vf = (bf16x8){a[0], a[1], a[2], a[3], b[0], b[1], b[2], b[3]}; oT0 = __builtin_amdgcn_mfma_f32_32x32x16_bf16(vf, p0, oT0, 0, 0, 0); } \
        { const s16x4 a = vtr(_v1), b = vtr(_v1 + 1024); const bf16x8 vf = (bf16x8){a[0], a[1], a[2], a[3], b[0], b[1], b[2], b[3]}; oT1 = __builtin_amdgcn_mfma_f32_32x32x16_bf16(vf, p0, oT1, 0, 0, 0); } \
        { const s16x4 a = vtr(_v0 + 2048), b = vtr(_v0 + 3072); const bf16x8 vf = (bf16x8){a[0], a[1], a[2], a[3], b[0], b[1], b[2], b[3]}; oT0 = __builtin_amdgcn_mfma_f32_32x32x16_bf16(vf, p1, oT0, 0, 0, 0); } \
        { const s16x4 a = vtr(_v1 + 2048), b = vtr(_v1 + 3072); const bf16x8 vf = (bf16x8){a[0], a[1], a[2], a[3], b[0], b[1], b[2], b[3]}; oT1 = __builtin_amdgcn_mfma_f32_32x32x16_bf16(vf, p1, oT1, 0, 0, 0); } } while (0)
#define ATT_SOFTMAX_PV(NT, sA, sB) do { \
        float _tm = sA[0]; _Pragma("unroll") for (int _r = 1; _r < 16; ++_r) _tm = fmaxf(_tm, sA[_r]); \
        if (NT == 2) { _Pragma("unroll") for (int _r = 0; _r < 16; ++_r) _tm = fmaxf(_tm, sB[_r]); } \
        _tm = fmaxf(_tm, __shfl_xor(_tm, 32)); \
        if (__any(_tm > m_run)) { const float _mn = fmaxf(m_run, _tm), _al = fexp2(m_run - _mn); m_run = _mn; l_run *= _al; \
            _Pragma("unroll") for (int _r = 0; _r < 16; ++_r) { oT0[_r] *= _al; oT1[_r] *= _al; } } \
        float _sum = 0.f, _sum2 = 0.f; _Pragma("unroll") for (int _r = 0; _r < 16; ++_r) { sA[_r] = fexp2(sA[_r] - m_run); _sum += sA[_r]; } \
        if (NT == 2) { _Pragma("unroll") for (int _r = 0; _r < 16; ++_r) { sB[_r] = fexp2(sB[_r] - m_run); _sum2 += sB[_r]; } } \
        l_run += _sum + _sum2; \
        bf16x8 _pa0, _pa1; ATT_PACK(_pa0, _pa1, sA); ATT_PV(0, _pa0, _pa1); \
        if (NT == 2) { bf16x8 _pb0, _pb1; ATT_PACK(_pb0, _pb1, sB); ATT_PV(1, _pb0, _pb1); } \
    } while (0)
#define ATT_WRITE_O(orow) do { \
        _Pragma("unroll") for (int _g = 0; _g < 4; ++_g) { \
            u32x2 w0, w1; w0.x = cvt_pk_bf16(oT0[4 * _g] * inv, oT0[4 * _g + 1] * inv); w0.y = cvt_pk_bf16(oT0[4 * _g + 2] * inv, oT0[4 * _g + 3] * inv); \
            w1.x = cvt_pk_bf16(oT1[4 * _g] * inv, oT1[4 * _g + 1] * inv); w1.y = cvt_pk_bf16(oT1[4 * _g + 2] * inv, oT1[4 * _g + 3] * inv); \
            *(u32x2*)((orow) + 8 * _g + 4 * hi) = w0; *(u32x2*)((orow) + 32 + 8 * _g + 4 * hi) = w1; } } while (0)
#define ATT_LANE_SETUP() \
    const int q32 = lane & 31, hi = lane >> 5; \
    const int wst = (lane >> 3) * 128 + (((lane & 7) ^ ((lane >> 3) & 7)) << 4);                         \
    const int kx = hi ^ (q32 & 7);                                                                        \
    const int vb0 = (4 * hi + ((lane & 15) >> 2)) * 128 + (((2 * ((lane >> 4) & 1) + ((lane & 3) >> 1)) ^ ((4 * hi + ((lane & 15) >> 2)) & 7)) << 4) + 8 * (lane & 1);

__device__ __forceinline__ void attnA_unit(int u, const bf16_t* proj, bf16_t* og, float* lse, int S, LAS unsigned char* wl, int lane) {
    ATT_LANE_SETUP()
    const int g = u / 2048, rem = u % 2048, h = rem / 512, idx = rem % 512;
    const int per_seq = S / 32, seq = idx / per_seq, ii = idx % per_seq;
    const int dsh = 2 * g, dl = 1 << dsh;
    const int r = ii & (dl - 1), c = ii >> dsh, L = S >> dsh;
    const int hd = 4 * g + h;
    const bf16_t* kbase = proj + (size_t)(12 + hd) * HSL; const bf16_t* vbase = proj + (size_t)(24 + hd) * HSL;
    const size_t seqbase = (size_t)seq * S;
    const size_t pbase = seqbase + (size_t)r * L;
    const int qm = 32 * c + q32;
    const size_t qtok = seqbase + (size_t)qm * dl + r;
    bf16x8 qr[4];
#pragma unroll
    for (int d = 0; d < 4; ++d) qr[d] = *(const bf16x8*)(proj + (size_t)hd * HSL + (pbase + qm) * 64 + 16 * d + 8 * hi);
    const int m0 = 32 * c - 64;
    float m_run = -1e29f, l_run = 0.f;
    f32x16 oT0 = F16Z, oT1 = F16Z;
    KVRegs Ra, Rb;
#define TOKA(t) (pbase + (size_t)min(max(m0 + 32 * (t) + _rowi, 0), L - 1))
#define A_MASK(s, t) do { const int kb0 = m0 + 32 * (t); \
        if (kb0 < 0 || kb0 + 32 > L) { \
            _Pragma("unroll") for (int rr = 0; rr < 16; ++rr) { const int km = kb0 + crow(rr, hi); const int dk = km - qm; \
                const bool ok = (km >= 0) && (km < L) && (dk <= 64) && (dk >= -64); s[rr] = ok ? s[rr] : NEGBIG; } \
        } else if ((t) == 0) { \
            _Pragma("unroll") for (int rr = 0; rr < 16; ++rr) s[rr] = (crow(rr, hi) >= q32) ? s[rr] : NEGBIG; \
        } else if ((t) == 4) { \
            _Pragma("unroll") for (int rr = 0; rr < 16; ++rr) s[rr] = (crow(rr, hi) <= q32) ? s[rr] : NEGBIG; \
        } } while (0)
    ATT_LOAD(Ra, TOKA(0)); ATT_LOAD(Rb, TOKA(1));
    ATT_STORE(Ra, 0); ATT_STORE(Rb, 1); ATT_LOAD(Ra, TOKA(2)); ATT_LOAD(Rb, TOKA(3));
    { f32x16 s0, s1; ATT_QK(s0, 0); ATT_QK(s1, 1); A_MASK(s0, 0); A_MASK(s1, 1); ATT_SOFTMAX_PV(2, s0, s1); }
    ATT_STORE(Ra, 0); ATT_STORE(Rb, 1); ATT_LOAD(Ra, TOKA(4));
    { f32x16 s0, s1; ATT_QK(s0, 0); ATT_QK(s1, 1); A_MASK(s0, 2); A_MASK(s1, 3); ATT_SOFTMAX_PV(2, s0, s1); }
    ATT_STORE(Ra, 0);
    { f32x16 s0; ATT_QK(s0, 0); A_MASK(s0, 4); ATT_SOFTMAX_PV(1, s0, s0); }
#undef A_MASK
#undef TOKA
    const float lt = l_run + __shfl_xor(l_run, 32);
    const float inv = frcp(lt);
    bf16_t* orow = og + qtok * 768 + hd * 64;
    ATT_WRITE_O(orow);
    if (hi == 0) lse[qtok * 12 + hd] = m_run + __builtin_amdgcn_logf(lt);
}

__device__ __forceinline__ void attnB_unit(int u, const bf16_t* proj, bf16_t* ob, int S, LAS unsigned char* wl, LAS const float* rpbL, int lane) {
    ATT_LANE_SETUP()
    const int h = u / 512, idx = u % 512;
    const int per_seq = S / 32, seq = idx / per_seq, ii = idx % per_seq;
    const int rp = ii >> 2, cc = ii & 3, rows = S / 64;
    const int ri0 = 2 * rp, qrow = ri0 + (q32 >> 4), qcolg = 16 * cc + (q32 & 15);
    const bf16_t* kbase = proj + (size_t)(44 + h) * HSL; const bf16_t* vbase = proj + (size_t)(52 + h) * HSL;
    const size_t seqbase = (size_t)seq * S;
    const size_t qtok = seqbase + (size_t)qrow * 64 + qcolg;
    bf16x8 qr[4];
#pragma unroll
    for (int d = 0; d < 4; ++d) qr[d] = *(const bf16x8*)(proj + (size_t)(36 + h) * HSL + qtok * 64 + 16 * d + 8 * hi);
    const int w0 = (cc == 0) ? 0 : (cc == 1) ? 8 : (cc == 2) ? 24 : 32;
    const int rs0 = min(max(ri0 - 4, 0), rows - 8), rs1 = min(max(ri0 - 3, 0), rows - 8);
    const int ntile = rs1 + 8 - rs0;
    const int rsq = min(max(qrow - 4, 0), rows - 8), csq = min(max(qcolg - 8, 0), 48);
    LAS const float* rb = rpbL + h * 465;
    const unsigned vmaskh = (0xFFFFu << (csq - w0)) >> (4 * hi);
    float m_run = -1e29f, l_run = 0.f;
    f32x16 oT0 = F16Z, oT1 = F16Z;
    KVRegs Ra, Rb;
#define TOKB(t) (seqbase + (size_t)(rs0 + (t)) * 64 + w0 + _rowi)
#define B_MASK(s, t) do { const int kr = rs0 + (t); const bool rowok = (kr >= rsq) && (kr < rsq + 8); \
        LAS const float* rbt = rb + ((kr - qrow + 7) * 31 + (w0 - qcolg + 15) + 4 * hi); \
        const unsigned mh = rowok ? vmaskh : 0u; float bv[16]; \
        _Pragma("unroll") for (int rr = 0; rr < 16; ++rr) bv[rr] = rbt[(rr & 3) + 8 * (rr >> 2)]; \
        _Pragma("unroll") for (int rr = 0; rr < 16; ++rr) { const int ko = (rr & 3) + 8 * (rr >> 2); const float sb = s[rr] + bv[rr]; s[rr] = (mh & (1u << ko)) ? sb : NEGBIG; } } while (0)
#define B_PAIR(t) do { f32x16 s0, s1; ATT_QK(s0, 0); ATT_QK(s1, 1); B_MASK(s0, (t)); B_MASK(s1, (t) + 1); ATT_SOFTMAX_PV(2, s0, s1); } while (0)
    ATT_LOAD(Ra, TOKB(0)); ATT_LOAD(Rb, TOKB(1));
    ATT_STORE(Ra, 0); ATT_STORE(Rb, 1); ATT_LOAD(Ra, TOKB(2)); ATT_LOAD(Rb, TOKB(3)); B_PAIR(0);
    ATT_STORE(Ra, 0); ATT_STORE(Rb, 1); ATT_LOAD(Ra, TOKB(4)); ATT_LOAD(Rb, TOKB(5)); B_PAIR(2);
    ATT_STORE(Ra, 0); ATT_STORE(Rb, 1); ATT_LOAD(Ra, TOKB(6)); ATT_LOAD(Rb, TOKB(7)); B_PAIR(4);
    ATT_STORE(Ra, 0); ATT_STORE(Rb, 1); if (ntile > 8) { ATT_LOAD(Ra, TOKB(8)); } B_PAIR(6);
    if (ntile > 8) { ATT_STORE(Ra, 0); f32x16 s0; ATT_QK(s0, 0); B_MASK(s0, 8); ATT_SOFTMAX_PV(1, s0, s0); }
#undef B_PAIR
#undef B_MASK
#undef TOKB
    const float lt = l_run + __shfl_xor(l_run, 32);
    const float inv = frcp(lt);
    bf16_t* orow = ob + qtok * 512 + h * 64;
    ATT_WRITE_O(orow);
}

#define XB_TMO      128
#define XB_XCNT(j)  (256  + 64 * (j))
#define XB_XSUB(j)  (1280 + 64 * (j))
#define XB_XGEN(j)  (2304 + 64 * (j))
#define XB_TOP      3328
#define XB_TOPGEN   3392
#define XCD_BAR_WORDS 3456
#define XB_SPIN_CAP (1u << 18)
__device__ __forceinline__ unsigned xb_ld(unsigned* p)              { return __hip_atomic_load(p, __ATOMIC_RELAXED, __HIP_MEMORY_SCOPE_AGENT); }
__device__ __forceinline__ unsigned xb_add(unsigned* p, unsigned v) { return __hip_atomic_fetch_add(p, v, __ATOMIC_RELAXED, __HIP_MEMORY_SCOPE_AGENT); }
__device__ __forceinline__ unsigned xb_xcc_id() { return (unsigned)__builtin_amdgcn_s_getreg((3 << 11) | 20) & 0xFu; }
#define XB_SPIN(cond, bar) do { unsigned _sp = 0; while (cond) { __builtin_amdgcn_s_sleep(1); \
    if ((++_sp & 255u) == 0u) { if (xb_ld(&(bar)[XB_TMO])) break; if (_sp > XB_SPIN_CAP) { atomicAdd(&(bar)[XB_TMO], 1u); break; } } } } while (0)
struct XcdBarrier { unsigned* bar; unsigned x; volatile LAS unsigned* st; };
__device__ __forceinline__ XcdBarrier xcd_barrier_post(unsigned* bar, volatile LAS unsigned* st) {
    XcdBarrier b; b.bar = bar; b.x = xb_xcc_id(); b.st = st;
    if (threadIdx.x == 0) (void)xb_add(&bar[XB_XCNT(b.x)], 1u);
    return b;
}
__device__ __forceinline__ void xcd_barrier_complete(unsigned* bar, unsigned x, unsigned& nloc, unsigned& nx) {
    const unsigned G = gridDim.x * gridDim.y * gridDim.z;
    unsigned sum, cnt, mine, sp = 0u;
    for (;;) {
        sum = 0u; cnt = 0u; mine = 0u;
#pragma unroll
        for (unsigned j = 0; j < 16; ++j) { const unsigned c = xb_ld(&bar[XB_XCNT(j)]); sum += c; cnt += (c > 0u) ? 1u : 0u; mine = (j == x) ? c : mine; }
        if (sum == G) break;
        __builtin_amdgcn_s_sleep(1);
        if ((++sp & 255u) == 0u) { if (xb_ld(&bar[XB_TMO])) break; if (sp > XB_SPIN_CAP) { atomicAdd(&bar[XB_TMO], 1u); break; } }
    }
    nloc = mine > 0u ? mine : 1u; nx = cnt > 0u ? cnt : 1u;
}
__device__ __forceinline__ void xcd_barrier(const XcdBarrier& b) {
    asm volatile("s_waitcnt vmcnt(0)" ::: "memory");
    __syncthreads();
    if (threadIdx.x == 0) {
        unsigned* bar = b.bar;
        __builtin_amdgcn_s_waitcnt(0);
        unsigned nloc = b.st[0], nx = b.st[1];
        if (nloc == 0u) { xcd_barrier_complete(bar, b.x, nloc, nx); b.st[0] = nloc; b.st[1] = nx; }
        const unsigned old = xb_add(&bar[XB_XSUB(b.x)], 1u);
        const unsigned gen = old / nloc;
        if (old + 1u == (gen + 1u) * nloc) {
            __builtin_amdgcn_fence(__ATOMIC_RELEASE, "agent");
            asm volatile("s_waitcnt vmcnt(0)" ::: "memory");
            const unsigned og = xb_add(&bar[XB_TOP], 1u);
            const unsigned tg = og / nx;
            if (og + 1u == (tg + 1u) * nx) xb_add(&bar[XB_TOPGEN], 1u);
            else XB_SPIN(xb_ld(&bar[XB_TOPGEN]) == tg, bar);
            __builtin_amdgcn_fence(__ATOMIC_ACQUIRE, "agent");
            xb_add(&bar[XB_XGEN(b.x)], 1u);
            asm volatile("s_waitcnt vmcnt(0)" ::: "memory");
        } else {
            XB_SPIN(xb_ld(&bar[XB_XGEN(b.x)]) == gen, bar);
            __builtin_amdgcn_fence(__ATOMIC_ACQUIRE, "agent");
            asm volatile("s_waitcnt vmcnt(0)" ::: "memory");
        }
    }
    __syncthreads();
}

#define CGSYNC() do { asm volatile("s_waitcnt vmcnt(0) lgkmcnt(0)" ::: "memory"); grid.sync(); __builtin_amdgcn_fence(__ATOMIC_ACQUIRE, "agent"); asm volatile("s_waitcnt vmcnt(0)" ::: "memory"); } while (0)
#define GSYNC() xcd_barrier(xbar)

template <int CH>
__device__ __forceinline__ void mixer_chunk(const XcdBarrier& xbar, LAS unsigned char* lds, int G, int gw, int NGW, const bf16_t* H, const bf16_t* Win, const bf16_t* Wa, const bf16_t* Wb, const bf16_t* Wout,
        bf16_t* proj, bf16_t* og, float* lse, bf16_t* oa, bf16_t* ob, bf16_t* Z, bf16_t* Dbuf, const float* rope, const float* bgate, const float* rpb) {
    int tid_ = threadIdx.x; asm volatile("" : "+v"(tid_));
    const int tid = tid_, lane = tid & 63, wid = __builtin_amdgcn_readfirstlane(tid >> 6);
    pg8::StaticOrder SO;
    const int gwx = ((G % 8 == 0) ? ((int)(blockIdx.x % 8) * (G / 8) + (int)(blockIdx.x / 8)) : (int)blockIdx.x) * NWAVES + wid;

        constexpr int ch = CH; constexpr int S = (CH == 0) ? 8192 : 16384;
        const bf16_t* Hc = H + (size_t)ch * TC * DM;
        { pg8::Gemm g{Hc, Win, TC, INW, DM}; SO.init(TC, INW, G, blockIdx.x); EpiProj E{proj, rope, bgate, S - 1, (S == 8192) ? 13 : 14}; pg8::gemm_phase(lds, g, SO, E); }
        GSYNC();
        {
            LAS unsigned char* wl = lds + wid * WAVE_LDS;
            for (int u = gwx; u < 3 * 4 * (TC / 32); u += NGW) { if (!SKIP_A) attnA_unit(u, proj, og, lse, S, wl, lane); }
        }
        GSYNC();
        {
            LAS float* rpbL = (LAS float*)(lds + RPB_OFF);
            for (int i = tid; i < 8 * 465; i += NTHR) rpbL[i] = rpb[i] * LOG2E;
            __syncthreads();
            LAS unsigned char* wl = lds + wid * WAVE_LDS;
            for (int u = gwx; u < 8 * (TC / 32); u += NGW) { if (!SKIP_B) attnB_unit(u, proj, ob, S, wl, rpbL, lane); }
            for (int i = blockIdx.x * NTHR + tid; i < TC * 32; i += G * NTHR) {
                const int tl = i >> 5, h = (i >> 3) & 3, c8 = i & 7;
                const float l0 = lse[tl * 12 + h], l1 = lse[tl * 12 + 4 + h], l2 = lse[tl * 12 + 8 + h];
                const float mx = fmaxf(l0, fmaxf(l1, l2));
                float e0 = fexp2(l0 - mx), e1 = fexp2(l1 - mx), e2 = fexp2(l2 - mx);
                const float is = frcp(e0 + e1 + e2); e0 *= is; e1 *= is; e2 *= is;
                const bf16_t* p = og + (size_t)tl * 768 + h * 64 + c8 * 8;
                const u32x4 v0 = *(const u32x4*)p, v1 = *(const u32x4*)(p + 256), v2 = *(const u32x4*)(p + 512);
                u32x4 w;
                w.x = cvt_pk_bf16(e0 * bf_lo(v0.x) + e1 * bf_lo(v1.x) + e2 * bf_lo(v2.x), e0 * bf_hi(v0.x) + e1 * bf_hi(v1.x) + e2 * bf_hi(v2.x));
                w.y = cvt_pk_bf16(e0 * bf_lo(v0.y) + e1 * bf_lo(v1.y) + e2 * bf_lo(v2.y), e0 * bf_hi(v0.y) + e1 * bf_hi(v1.y) + e2 * bf_hi(v2.y));
                w.z = cvt_pk_bf16(e0 * bf_lo(v0.z) + e1 * bf_lo(v1.z) + e2 * bf_lo(v2.z), e0 * bf_hi(v0.z) + e1 * bf_hi(v1.z) + e2 * bf_hi(v2.z));
                w.w = cvt_pk_bf16(e0 * bf_lo(v0.w) + e1 * bf_lo(v1.w) + e2 * bf_lo(v2.w), e0 * bf_hi(v0.w) + e1 * bf_hi(v1.w) + e2 * bf_hi(v2.w));
                *(u32x4*)(oa + (size_t)tl * 256 + h * 64 + c8 * 8) = w;
            }
        }
        GSYNC();
        { pg8::Gemm g{oa, Wa, TC, DM, 256}; SO.init(TC, DM, G, blockIdx.x); EpiGate<false> E{Z, proj, 0}; pg8::gemm_phase(lds, g, SO, E); }
        { pg8::Gemm g{ob, Wb, TC, DM, 512}; SO.init(TC, DM, G, blockIdx.x); EpiGate<true> E{Z, proj, DM}; pg8::gemm_phase(lds, g, SO, E); }
        GSYNC();
        { pg8::Gemm g{Z, Wout, TC, DM, DM}; SO.init(TC, DM, G, blockIdx.x); EpiPlain E{Dbuf + (size_t)ch * TC * DM, DM}; pg8::gemm_phase(lds, g, SO, E); }

}

__global__ void __launch_bounds__(NTHR, 2) enc_fwd(Args a) {
    extern __shared__ __attribute__((aligned(16))) unsigned char lds_raw[];
    LAS unsigned char* lds = (LAS unsigned char*)lds_raw;
    cg::grid_group grid = cg::this_grid();
    const int tid = threadIdx.x, lane = tid & 63, wid = __builtin_amdgcn_readfirstlane(tid >> 6);
    const int G = gridDim.x, gw = blockIdx.x * NWAVES + wid, NGW = G * NWAVES;
    unsigned char* ws = a.ws;
    const float* x_p = a.in[0]; const float* x_s = a.in[1];
    bf16_t* Wgu1 = (bf16_t*)(ws + WS_WGU1); bf16_t* Wd1 = (bf16_t*)(ws + WS_WD1); bf16_t* Win = (bf16_t*)(ws + WS_WIN);
    bf16_t* Wa = (bf16_t*)(ws + WS_WA); bf16_t* Wb = (bf16_t*)(ws + WS_WB); bf16_t* Wout = (bf16_t*)(ws + WS_WOUT);
    bf16_t* Wgu2 = (bf16_t*)(ws + WS_WGU2); bf16_t* Wd2 = (bf16_t*)(ws + WS_WD2);
    float* rope = (float*)(ws + WS_ROPE); float* lse = (float*)(ws + WS_LSE);
    bf16_t* H = (bf16_t*)(ws + WS_H); bf16_t* A1 = (bf16_t*)(ws + WS_A1); bf16_t* Dbuf = (bf16_t*)(ws + WS_D); bf16_t* XB = (bf16_t*)(ws + WS_XB);
    bf16_t* proj = (bf16_t*)(ws + WS_PROJ); bf16_t* og = (bf16_t*)(ws + WS_OG); bf16_t* oa = (bf16_t*)(ws + WS_OA); bf16_t* ob = (bf16_t*)(ws + WS_OB); bf16_t* Z = (bf16_t*)(ws + WS_Z);
    float* out = a.out;
    volatile LAS unsigned* xst = (volatile LAS unsigned*)(lds + 131072 + 15360);
    if (tid < 2) xst[tid] = 0u;
    __syncthreads();
    const XcdBarrier xbar = xcd_barrier_post((unsigned*)(ws + WS_BAR), xst);
    grid.sync();

    {
        LAS float* scr = (LAS float*)lds;
        transpose_block<1>(a.in[4], a.in[5], FF, Wgu1, DM, 2 * FF, scr, tid, blockIdx.x, G);
        transpose_block<0>(a.in[6], nullptr, DM, Wd1, FF, DM, scr, tid, blockIdx.x, G);
        transpose_block<2>(a.in[9], nullptr, INW, Win, DM, INW, scr, tid, blockIdx.x, G);
        transpose_block<0>(a.in[12], nullptr, DM, Wa, 256, DM, scr, tid, blockIdx.x, G);
        transpose_block<0>(a.in[13], nullptr, DM, Wb, 512, DM, scr, tid, blockIdx.x, G);
        transpose_block<0>(a.in[14], nullptr, DM, Wout, DM, DM, scr, tid, blockIdx.x, G);
        transpose_block<1>(a.in[17], a.in[18], FF, Wgu2, DM, 2 * FF, scr, tid, blockIdx.x, G);
        transpose_block<0>(a.in[19], nullptr, DM, Wd2, FF, DM, scr, tid, blockIdx.x, G);
        for (int i = blockIdx.x * NTHR + tid; i < 16384 * 8; i += G * NTHR) {
            const int pos = i >> 3, f = i & 7;
            const double invf = (f == 0) ? 1.0 : (f == 1) ? 0.19392274474868576 : (f == 2) ? 0.03760603093086393 : (f == 3) ? 0.007292664737217109 : (f == 4) ? 0.001414213562373095
                              : (f == 5) ? 0.0002742481756762073 : (f == 6) ? 5.318295896944988e-05 : 1.031338537721246e-05;
            const float angf = (float)pos * (float)invf;
            double tt = (double)angf * 0.15915494309189535; tt -= floor(tt);
            const float fr = (float)tt;
            rope[pos * 16 + f] = __builtin_amdgcn_cosf(fr); rope[pos * 16 + 8 + f] = __builtin_amdgcn_sinf(fr);
        }
        row_pass<false, true, false, false>(x_p, x_s, nullptr, nullptr, nullptr, 0.f, nullptr, nullptr, a.in[2], H, lane, gw, NGW);
    }
    GSYNC();
    pg8::StaticOrder SO;
    { pg8::Gemm g{H, Wgu1, TALL, 2 * FF, DM}; SO.init(TALL, 2 * FF, G, blockIdx.x); EpiSwiglu E{A1}; pg8::gemm_phase(lds, g, SO, E); }
    GSYNC();
    { pg8::Gemm g{A1, Wd1, TALL, DM, FF}; SO.init(TALL, DM, G, blockIdx.x); EpiPlain E{Dbuf, DM}; pg8::gemm_phase(lds, g, SO, E); }
    GSYNC();
    row_pass<true, true, false, true>(x_p, x_s, nullptr, Dbuf, a.in[3], 0.5f, nullptr, XB, a.in[7], H, lane, gw, NGW);
    GSYNC();
    if (STOP_AFTER <= 1) return;
    if (STOP_AFTER <= 1) return;
    mixer_chunk<0>(xbar, lds, G, gw, NGW, H, Win, Wa, Wb, Wout, proj, og, lse, oa, ob, Z, Dbuf, rope, a.in[10], a.in[11]);
    mixer_chunk<1>(xbar, lds, G, gw, NGW, H, Win, Wa, Wb, Wout, proj, og, lse, oa, ob, Z, Dbuf, rope, a.in[10], a.in[11]);
    mixer_chunk<2>(xbar, lds, G, gw, NGW, H, Win, Wa, Wb, Wout, proj, og, lse, oa, ob, Z, Dbuf, rope, a.in[10], a.in[11]);
    GSYNC();
    row_pass<true, true, true, true>(nullptr, nullptr, XB, Dbuf, a.in[8], 1.0f, nullptr, XB, a.in[15], H, lane, gw, NGW);
    GSYNC();
    if (STOP_AFTER <= 2) return;
    if (STOP_AFTER <= 2) return;
    { pg8::Gemm g{H, Wgu2, TALL, 2 * FF, DM}; SO.init(TALL, 2 * FF, G, blockIdx.x); EpiSwiglu E{A1}; pg8::gemm_phase(lds, g, SO, E); }
    GSYNC();
    { pg8::Gemm g{A1, Wd2, TALL, DM, FF}; SO.init(TALL, DM, G, blockIdx.x); EpiPlain E{Dbuf, DM}; pg8::gemm_phase(lds, g, SO, E); }
    GSYNC();
    row_pass<true, false, true, false>(nullptr, nullptr, XB, Dbuf, a.in[16], 0.5f, out, nullptr, nullptr, nullptr, lane, gw, NGW);
}

extern "C" void kernel_launch(void* const* d_in, const int* in_sizes, int n_in, void* d_out, int out_size, void* d_ws, size_t ws_size, hipStream_t stream) {
    static int grid = 0;
    if (grid == 0) {
        if (n_in != 20 || out_size != TALL * DM || ws_size < WS_END) { fprintf(stderr, "kernel_launch: unexpected shapes (n_in %d out %d ws %zu)\n", n_in, out_size, ws_size); grid = -1; return; }
        int dev = 0, cus = 0, per_cu = 0;
        hipGetDevice(&dev);
        hipDeviceGetAttribute(&cus, hipDeviceAttributeMultiprocessorCount, dev);
        hipFuncSetAttribute((const void*)enc_fwd, hipFuncAttributeMaxDynamicSharedMemorySize, LDS_BYTES);
        hipOccupancyMaxActiveBlocksPerMultiprocessor(&per_cu, (const void*)enc_fwd, NTHR, LDS_BYTES);
        if (per_cu < 1) per_cu = 1;
        grid = cus * per_cu;
        (void)hipGetLastError();
    }
    if (grid < 0) return;
    if (hipMemsetAsync((char*)d_ws + WS_BAR, 0, 16384, stream) != hipSuccess) { fprintf(stderr, "memset of barrier words failed\n"); return; }
    Args a{};
    for (int i = 0; i < 20; ++i) a.in[i] = (const float*)d_in[i];
    a.out = (float*)d_out; a.ws = (unsigned char*)d_ws;
    void* args[] = {&a};
    hipError_t e = hipLaunchCooperativeKernel((const void*)enc_fwd, dim3(grid), dim3(NTHR), args, LDS_BYTES, stream);
    if (e != hipSuccess) fprintf(stderr, "cooperative launch failed: %s (grid %d)\n", hipGetErrorString(e), grid);
}
```
